# Optimizing an MI355X kernel written in HIP

```python
import math
import jax, jax.numpy as jnp
from jax import lax
import numpy as np

D_MODEL = 1024
BATCH = 4
SEQ = 4096
DEPTH = 2

N_MEM = 256
N_BRANCH = 3
BRANCH_W = D_MODEL // 2
LRU_BLOCKS = 4
LRU_BLOCK = BRANCH_W // LRU_BLOCKS
CONV_W = 4
LRU_C = 8.0
GLA_HEADS = 4
GLA_DV = BRANCH_W // GLA_HEADS
GLA_DK = GLA_DV // 2
GLA_KW = GLA_HEADS * GLA_DK
GLA_RANK = 16
GLA_TAU = 16.0
GLA_CHUNK = 64
S5_GROUP = 16
S5_GROUPS = BRANCH_W // S5_GROUP
S5_STATE = 64
XA_HEADS = 4
XA_HD = D_MODEL // XA_HEADS
D_FF = -(-8 * D_MODEL // (3 * 256)) * 256
DN_ALPHA = (2 * DEPTH) ** 0.25
DN_BETA = (8 * DEPTH) ** -0.25
LN_EPS = 1e-5

IN_SIZES = (BRANCH_W, BRANCH_W,
            GLA_KW, GLA_KW, BRANCH_W,
            BRANCH_W, GLA_RANK,
            BRANCH_W,
            N_BRANCH * D_MODEL)
D_IN = sum(IN_SIZES)
IN_SPLITS = tuple(int(s) for s in np.cumsum(IN_SIZES)[:-1])

kernel_name = 'hybrid_rglru_gla_s5_deepnorm'


def layer_norm(x, g, b):
    xf = x.astype(jnp.float32)
    mu = jnp.mean(xf, axis=-1, keepdims=True)
    var = jnp.mean(jnp.square(xf - mu), axis=-1, keepdims=True)
    return ((xf - mu) * lax.rsqrt(var + LN_EPS)).astype(x.dtype) * g + b


def rms_norm(x, g):
    xf = x.astype(jnp.float32)
    return (xf * lax.rsqrt(jnp.mean(xf * xf, axis=-1, keepdims=True) + LN_EPS)).astype(x.dtype) * g


def causal_dwconv(u, w, b):
    L = u.shape[1]
    up = jnp.pad(u, ((0, 0), (CONV_W - 1, 0), (0, 0)))
    out = b + up[:, 0:L] * w[0]
    for k in range(1, CONV_W):
        out = out + up[:, k:k + L] * w[k]
    return out


def _linear_combine(e1, e2):
    a1, b1 = e1
    a2, b2 = e2
    return a1 * a2, a2 * b1 + b2


def rg_lru(u, w_a, b_a, w_i, b_i, lam):
    B_, L, _ = u.shape
    ub = u.reshape(B_, L, LRU_BLOCKS, LRU_BLOCK)
    r = jax.nn.sigmoid(jnp.einsum('blhi,hij->blhj', ub, w_a).reshape(B_, L, BRANCH_W) + b_a)
    i = jax.nn.sigmoid(jnp.einsum('blhi,hij->blhj', ub, w_i).reshape(B_, L, BRANCH_W) + b_i)
    log_a = -LRU_C * r * jax.nn.softplus(-lam)
    a = jnp.exp(log_a)
    mult = jnp.sqrt(-jnp.expm1(2.0 * log_a))
    _, h = lax.associative_scan(_linear_combine, (a, mult * (i * u)), axis=1)
    return h


def gla_chunked(q, k, v, log_f):
    B_, L = q.shape[0], q.shape[1]
    NC = L // GLA_CHUNK

    def chunks(t):
        return t.reshape(B_, NC, GLA_CHUNK, GLA_HEADS, t.shape[-1]).transpose(0, 3, 1, 2, 4)

    q, k, v, g = chunks(q) * GLA_DK ** -0.5, chunks(k), chunks(v), chunks(log_f)
    b = jnp.cumsum(g, axis=3)
    b_last = b[:, :, :, -1:]
    q_dec = q * jnp.exp(b)
    k_inv = k * jnp.exp(-b)
    k_end = k * jnp.exp(b_last - b)
    causal = jnp.tril(jnp.ones((GLA_CHUNK, GLA_CHUNK), dtype=bool))
    att = jnp.where(causal, jnp.einsum('bhnck,bhnsk->bhncs', q_dec, k_inv), 0.0)
    o_intra = jnp.einsum('bhncs,bhnsv->bhncv', att, v)
    d_state = jnp.einsum('bhnsk,bhnsv->bhnkv', k_end, v)
    decay = jnp.exp(b_last[:, :, :, 0])

    def step(S, inp):
        dec, ds = inp
        return dec[..., None] * S + ds, S

    S0 = jnp.zeros((B_, GLA_HEADS, GLA_DK, GLA_DV), q.dtype)
    _, S_prev = lax.scan(step, S0, (jnp.moveaxis(decay, 2, 0), jnp.moveaxis(d_state, 2, 0)))
    S_prev = jnp.moveaxis(S_prev, 0, 2)
    o = o_intra + jnp.einsum('bhnck,bhnkv->bhncv', q_dec, S_prev)
    return o.transpose(0, 2, 3, 1, 4).reshape(B_, L, GLA_HEADS, GLA_DV)


def s5_ssm(u, lam_re, lam_im, log_dt, b_re, b_im, c_re, c_im, d_skip):
    B_, L, _ = u.shape
    dt = jnp.exp(log_dt)[:, None]
    mag = jnp.exp(lam_re * dt)
    ab_re = mag * jnp.cos(lam_im * dt)
    ab_im = mag * jnp.sin(lam_im * dt)
    den = lam_re * lam_re + lam_im * lam_im
    f_re = ((ab_re - 1.0) * lam_re + ab_im * lam_im) / den
    f_im = (ab_im * lam_re - (ab_re - 1.0) * lam_im) / den
    bb_re = f_re[..., None] * b_re - f_im[..., None] * b_im
    bb_im = f_re[..., None] * b_im + f_im[..., None] * b_re
    ug = u.reshape(B_, L, S5_GROUPS, S5_GROUP)
    bu_re = jnp.einsum('blgi,gpi->blgp', ug, bb_re)
    bu_im = jnp.einsum('blgi,gpi->blgp', ug, bb_im)
    a_re = jnp.broadcast_to(ab_re, (1, L, S5_GROUPS, S5_STATE))
    a_im = jnp.broadcast_to(ab_im, (1, L, S5_GROUPS, S5_STATE))

    def combine(e1, e2):
        a1r, a1i, b1r, b1i = e1
        a2r, a2i, b2r, b2i = e2
        return (a2r * a1r - a2i * a1i, a2r * a1i + a2i * a1r,
                a2r * b1r - a2i * b1i + b2r, a2r * b1i + a2i * b1r + b2i)

    _, _, xr, xi = lax.associative_scan(combine, (a_re, a_im, bu_re, bu_im), axis=1)
    y = jnp.einsum('blgp,gip->blgi', xr, c_re) - jnp.einsum('blgp,gip->blgi', xi, c_im)
    return y.reshape(B_, L, BRANCH_W) + d_skip * u


def hybrid_mixer(h, w_in, b_in, conv_w, conv_b, lru_w_a, lru_b_a, lru_w_i, lru_b_i, lru_lambda,
                 gla_w_lr, gla_b_lr, gla_norm_g,
                 s5_lam_re, s5_lam_im, s5_log_dt, s5_b_re, s5_b_im, s5_c_re, s5_c_im, s5_d,
                 s5_w_glu, s5_b_glu, w_branch, w_mix_out):
    B_, L, _ = h.shape
    proj = h @ w_in + b_in
    u_lru, g_lru, q, k, v, og, lr, u_s5, gate_logits = jnp.split(proj, IN_SPLITS, axis=-1)
    y_a = rg_lru(causal_dwconv(u_lru, conv_w, conv_b), lru_w_a, lru_b_a, lru_w_i, lru_b_i,
                 lru_lambda) * jax.nn.gelu(g_lru)
    log_f = jax.nn.log_sigmoid(lr @ gla_w_lr + gla_b_lr) / GLA_TAU
    o = gla_chunked(q.reshape(B_, L, GLA_HEADS, GLA_DK), k.reshape(B_, L, GLA_HEADS, GLA_DK),
                    v.reshape(B_, L, GLA_HEADS, GLA_DV), log_f.reshape(B_, L, GLA_HEADS, GLA_DK))
    y_b = rms_norm(o, gla_norm_g).reshape(B_, L, BRANCH_W) * jax.nn.silu(og)
    z = jax.nn.gelu(s5_ssm(u_s5, s5_lam_re, s5_lam_im, s5_log_dt, s5_b_re, s5_b_im,
                           s5_c_re, s5_c_im, s5_d))
    y_c = z * jax.nn.sigmoid(z @ s5_w_glu + s5_b_glu)
    ys = jnp.stack([y_a, y_b, y_c], axis=2)
    gates = jax.nn.sigmoid(gate_logits.reshape(B_, L, N_BRANCH, D_MODEL))
    merged = jnp.sum(gates * jnp.einsum('blnw,nwd->blnd', ys, w_branch), axis=2)
    return merged @ w_mix_out


def cross_attention(h, mem, w_q, w_kv, w_o):
    B_, L, _ = h.shape
    q = (h @ w_q).reshape(B_, L, XA_HEADS, XA_HD)
    k, v = jnp.split(mem @ w_kv, 2, axis=-1)
    k = k.reshape(B_, -1, XA_HEADS, XA_HD)
    v = v.reshape(B_, -1, XA_HEADS, XA_HD)
    s = jnp.einsum('blhd,bmhd->bhlm', q, k) * XA_HD ** -0.5
    p = jax.nn.softmax(s.astype(jnp.float32), axis=-1).astype(v.dtype)
    o = jnp.einsum('bhlm,bmhd->blhd', p, v).reshape(B_, L, D_MODEL)
    return o @ w_o


def swiglu(h, w_gu, w_down):
    gate, up = jnp.split(h @ w_gu, 2, axis=-1)
    return (jax.nn.silu(gate) * up) @ w_down


def setup_inputs(seed: int = 0) -> dict:
    key = jax.random.key(seed)
    ks = iter(jax.random.split(key, 64))

    def nrm(shape, scale):
        return jax.random.normal(next(ks), shape, jnp.float32) * scale

    def gain(shape):
        return 1.0 + nrm(shape, 0.01)

    N = DEPTH
    u = jax.random.uniform(next(ks), (N, BRANCH_W), jnp.float32, 0.9, 0.999)
    s = u ** (1.0 / LRU_C)
    lru_lambda = jnp.log(s) - jnp.log1p(-s)
    n_idx = jnp.arange(S5_STATE, dtype=jnp.float32)
    log_dt = jax.random.uniform(next(ks), (N, S5_GROUPS), jnp.float32,
                                math.log(1e-3), math.log(1e-1))
    return {
        'x': nrm((BATCH, SEQ, D_MODEL), 1.0),
        'mem': nrm((BATCH, N_MEM, D_MODEL), 1.0),
        'ln_in_g': gain((D_MODEL,)),
        'ln_in_b': nrm((D_MODEL,), 0.01),
        'w_in': nrm((N, D_MODEL, D_IN), D_MODEL ** -0.5),
        'b_in': nrm((N, D_IN), 0.01),
        'lru_conv_w': nrm((N, CONV_W, BRANCH_W), CONV_W ** -0.5),
        'lru_conv_b': nrm((N, BRANCH_W), 0.01),
        'lru_w_a': nrm((N, LRU_BLOCKS, LRU_BLOCK, LRU_BLOCK), LRU_BLOCK ** -0.5),
        'lru_b_a': nrm((N, BRANCH_W), 0.01),
        'lru_w_i': nrm((N, LRU_BLOCKS, LRU_BLOCK, LRU_BLOCK), LRU_BLOCK ** -0.5),
        'lru_b_i': nrm((N, BRANCH_W), 0.01),
        'lru_lambda': lru_lambda,
        'gla_w_lr': nrm((N, GLA_RANK, GLA_KW), GLA_RANK ** -0.5),
        'gla_b_lr': nrm((N, GLA_KW), 0.01),
        'gla_norm_g': gain((N, GLA_DV)),
        's5_lam_re': -0.5 + nrm((N, S5_GROUPS, S5_STATE), 0.01),
        's5_lam_im': math.pi * n_idx + nrm((N, S5_GROUPS, S5_STATE), 0.01),
        's5_log_dt': log_dt,
        's5_b_re': nrm((N, S5_GROUPS, S5_STATE, S5_GROUP), (2 * S5_GROUP) ** -0.5),
        's5_b_im': nrm((N, S5_GROUPS, S5_STATE, S5_GROUP), (2 * S5_GROUP) ** -0.5),
        's5_c_re': nrm((N, S5_GROUPS, S5_GROUP, S5_STATE), (2 * S5_STATE) ** -0.5),
        's5_c_im': nrm((N, S5_GROUPS, S5_GROUP, S5_STATE), (2 * S5_STATE) ** -0.5),
        's5_d': nrm((N, BRANCH_W), 1.0),
        's5_w_glu': nrm((N, BRANCH_W, BRANCH_W), BRANCH_W ** -0.5),
        's5_b_glu': nrm((N, BRANCH_W), 0.01),
        'w_branch': nrm((N, N_BRANCH, BRANCH_W, D_MODEL), BRANCH_W ** -0.5),
        'w_mix_out': nrm((N, D_MODEL, D_MODEL), D_MODEL ** -0.5 * DN_BETA),
        'ln1_g': gain((N, D_MODEL)),
        'ln1_b': nrm((N, D_MODEL), 0.01),
        'xa_w_q': nrm((N, D_MODEL, D_MODEL), D_MODEL ** -0.5),
        'xa_w_kv': nrm((N, D_MODEL, 2 * D_MODEL), D_MODEL ** -0.5),
        'xa_w_o': nrm((N, D_MODEL, D_MODEL), D_MODEL ** -0.5 * DN_BETA),
        'ln2_g': gain((N, D_MODEL)),
        'ln2_b': nrm((N, D_MODEL), 0.01),
        'ffn_w_gu': nrm((N, D_MODEL, 2 * D_FF), D_MODEL ** -0.5),
        'ffn_w_down': nrm((N, D_FF, D_MODEL), D_FF ** -0.5 * DN_BETA),
        'ln3_g': gain((N, D_MODEL)),
        'ln3_b': nrm((N, D_MODEL), 0.01),
    }


def reference(x, mem, ln_in_g, ln_in_b, w_in, b_in, lru_conv_w, lru_conv_b, lru_w_a, lru_b_a,
              lru_w_i, lru_b_i, lru_lambda, gla_w_lr, gla_b_lr, gla_norm_g,
              s5_lam_re, s5_lam_im, s5_log_dt, s5_b_re, s5_b_im, s5_c_re, s5_c_im, s5_d,
              s5_w_glu, s5_b_glu, w_branch, w_mix_out, ln1_g, ln1_b,
              xa_w_q, xa_w_kv, xa_w_o, ln2_g, ln2_b, ffn_w_gu, ffn_w_down, ln3_g, ln3_b):
    h = layer_norm(x, ln_in_g, ln_in_b)
    for l in range(DEPTH):
        mix = hybrid_mixer(h, w_in[l], b_in[l], lru_conv_w[l], lru_conv_b[l], lru_w_a[l],
                           lru_b_a[l], lru_w_i[l], lru_b_i[l], lru_lambda[l],
                           gla_w_lr[l], gla_b_lr[l], gla_norm_g[l],
                           s5_lam_re[l], s5_lam_im[l], s5_log_dt[l], s5_b_re[l], s5_b_im[l],
                           s5_c_re[l], s5_c_im[l], s5_d[l], s5_w_glu[l], s5_b_glu[l],
                           w_branch[l], w_mix_out[l])
        h = layer_norm(DN_ALPHA * h + mix, ln1_g[l], ln1_b[l])
        h = layer_norm(DN_ALPHA * h + cross_attention(h, mem, xa_w_q[l], xa_w_kv[l], xa_w_o[l]),
                       ln2_g[l], ln2_b[l])
        h = layer_norm(DN_ALPHA * h + swiglu(h, ffn_w_gu[l], ffn_w_down[l]), ln3_g[l], ln3_b[l])
    return h
```

```cpp
#include <hip/hip_runtime.h>
#include <hip/hip_cooperative_groups.h>
#include <cstdio>
namespace cg = cooperative_groups;

#ifndef SINGLE_LAUNCH
#define SINGLE_LAUNCH 1
#endif

typedef unsigned short bf16_t;
typedef short bf16x8 __attribute__((ext_vector_type(8)));
typedef float f32x4 __attribute__((ext_vector_type(4)));

constexpr int NTOK = 16384, DM = 1024, SEQ = 4096, NB = 4;
constexpr int PROJ_LD = 3200;
constexpr int C_ULRU = 0, C_GLRU = 512, C_Q = 1024, C_K = 1280, C_V = 1536, C_OG = 2048, C_LR = 2560, C_US5 = 2576;
constexpr int DFF = 2816;
constexpr float DN_ALPHA = 1.4142135623730951f;
constexpr float LN_EPS = 1e-5f;

constexpr size_t WT_IN = 0;
constexpr size_t WT_LRU = WT_IN + 6272ull * 1024 * 2;
constexpr size_t WT_GLU = WT_LRU + 4ull * 256 * 128 * 2;
constexpr size_t WT_BR = WT_GLU + 512ull * 512 * 2;
constexpr size_t WT_MIX = WT_BR + 3ull * 1024 * 512 * 2;
constexpr size_t OFF_HB = WT_MIX + 1024ull * 1024 * 2;
constexpr size_t OFF_MEMB = OFF_HB + 16384ull * 1024 * 2;
constexpr size_t OFF_R3 = OFF_MEMB + 1024ull * 1024 * 2;
constexpr size_t OFF_R4 = OFF_R3 + 16384ull * 3200 * 2;
constexpr size_t OFF_UC = OFF_R4;
constexpr size_t OFF_GL = OFF_R4 + 16384ull * 512 * 2;
constexpr size_t OFF_R5 = OFF_GL + 16384ull * 1024 * 2;
constexpr size_t OFF_S5C = OFF_R5 + 1024ull * 8192 * 4;
constexpr size_t OFF_LRUP = OFF_S5C + 4ull * 64 * 32 * 64 * 8;
constexpr size_t OFF_LRUH = OFF_LRUP + 4ull * 64 * 512 * 4;
constexpr size_t OFF_DEC = OFF_LRUH + 4ull * 64 * 512 * 4;
constexpr size_t OFF_KB = OFF_DEC + 1024ull * 64 * 4;
constexpr size_t OFF_VT = OFF_KB + 1024ull * 1024 * 2;
constexpr size_t WS_END = OFF_VT + 4ull * 1024 * 256 * 2;
constexpr size_t WT_Q = OFF_GL;
constexpr size_t WT_KV = WT_Q + 1024ull * 1024 * 2;
constexpr size_t WT_O = WT_KV + 2048ull * 1024 * 2;
constexpr size_t WT_GU = WT_O + 1024ull * 1024 * 2;
constexpr size_t WT_DN = WT_GU + 5632ull * 1024 * 2;
static_assert(WT_DN + 1024ull * 2816 * 2 <= OFF_R5, "wb overflow");
constexpr size_t OFF_XQ = OFF_R3;
constexpr size_t OFF_XS = OFF_R3 + 16384ull * 1024 * 2;
constexpr size_t OFF_XO = OFF_XS + 16384ull * 1024 * 2;
constexpr size_t OFF_ACT = OFF_R3;

constexpr int SMEM_BYTES = 2 * (256 * 144);

struct CJob { const float* src; bf16_t* dst; int ld, K, mode, tile_end; };
constexpr int NWA = 14, NWB = 5;
struct Params {
    const float* in[39];
    float* out;
    char* ws;
    CJob wa[2][NWA];
    CJob wb[2][NWB];
    int ph_lo, ph_hi;
};

__device__ __forceinline__ int TIDX() { int t = threadIdx.x; asm volatile("" : "+v"(t)); return t; }
__device__ __forceinline__ float bf2f(bf16_t b) { return __uint_as_float(((unsigned)b) << 16); }
__device__ __forceinline__ unsigned cvt_pk_bf16(float lo, float hi) { unsigned r; asm volatile("v_cvt_pk_bf16_f32 %0, %1, %2" : "=v"(r) : "v"(lo), "v"(hi)); return r; }
__device__ __forceinline__ bf16_t f2bf(float f) { return (bf16_t)(cvt_pk_bf16(f, 0.f) & 0xffffu); }
__device__ __forceinline__ float lo_bf(unsigned u) { return __uint_as_float(u << 16); }
__device__ __forceinline__ float hi_bf(unsigned u) { return __uint_as_float(u & 0xffff0000u); }
__device__ __forceinline__ float sigmoid_(float x) { return 1.f / (1.f + __expf(-x)); }
__device__ __forceinline__ float gelu_t(float x) { float u = 1.5957691216057308f * (x + 0.044715f * x * x * x); return x / (1.f + __expf(-u)); }
__device__ __forceinline__ float logsigmoid_(float x) { return fminf(x, 0.f) - log1pf(__expf(-fabsf(x))); }
__device__ __forceinline__ uint2 pack4(f32x4 v) { uint2 r; r.x = cvt_pk_bf16(v[0], v[1]); r.y = cvt_pk_bf16(v[2], v[3]); return r; }
__device__ __forceinline__ float wave_sum(float v) {
#pragma unroll
    for (int o = 32; o > 0; o >>= 1) v += __shfl_xor(v, o);
    return v;
}
__device__ __forceinline__ float wave_max(float v) {
#pragma unroll
    for (int o = 32; o > 0; o >>= 1) v = fmaxf(v, __shfl_xor(v, o));
    return v;
}

template <int MT>
__device__ __forceinline__ void gemm_mainloop(f32x4 (&acc)[MT][4], const bf16_t* __restrict__ A, int lda, const bf16_t* __restrict__ Bt, int ldb, int K, char* smem) {
    constexpr int BM = MT * 32;
    constexpr int A_BYTES = BM * 144, STAGE = A_BYTES + 128 * 144;
    constexpr int NA = MT;
    const int tid = TIDX(), lane = tid & 63, wave = tid >> 6, wr = wave >> 1, wc = wave & 1;
    const int prow = tid >> 3, pc = tid & 7;
    const bf16_t* ag = A + (size_t)prow * lda + pc * 8;
    const bf16_t* bg = Bt + (size_t)prow * ldb + pc * 8;
    const int soff = prow * 144 + pc * 16;
    const int fa = (wr * MT * 16 + (lane & 15)) * 144 + (lane >> 4) * 16;
    const int fb = A_BYTES + (wc * 64 + (lane & 15)) * 144 + (lane >> 4) * 16;
    uint4 ra[NA], rb[4];
    const int nk = K >> 6;
#pragma unroll
    for (int i = 0; i < NA; ++i) ra[i] = *(const uint4*)(ag + (size_t)(i * 32) * lda);
#pragma unroll
    for (int i = 0; i < 4; ++i) rb[i] = *(const uint4*)(bg + (size_t)(i * 32) * ldb);
#pragma unroll
    for (int i = 0; i < NA; ++i) *(uint4*)(smem + soff + i * 32 * 144) = ra[i];
#pragma unroll
    for (int i = 0; i < 4; ++i) *(uint4*)(smem + A_BYTES + soff + i * 32 * 144) = rb[i];
    __syncthreads();
    for (int kt = 0; kt < nk; ++kt) {
        const bool more = (kt + 1 < nk);
        if (more) {
#pragma unroll
            for (int i = 0; i < NA; ++i) ra[i] = *(const uint4*)(ag + (size_t)(i * 32) * lda + (kt + 1) * 64);
#pragma unroll
            for (int i = 0; i < 4; ++i) rb[i] = *(const uint4*)(bg + (size_t)(i * 32) * ldb + (kt + 1) * 64);
        }
        const char* st = smem + (kt & 1) * STAGE;
#pragma unroll
        for (int ks = 0; ks < 2; ++ks) {
            bf16x8 af[MT], bfr[4];
#pragma unroll
            for (int mi = 0; mi < MT; ++mi) af[mi] = *(const bf16x8*)(st + fa + mi * 16 * 144 + ks * 64);
#pragma unroll
            for (int ni = 0; ni < 4; ++ni) bfr[ni] = *(const bf16x8*)(st + fb + ni * 16 * 144 + ks * 64);
#pragma unroll
            for (int mi = 0; mi < MT; ++mi)
#pragma unroll
                for (int ni = 0; ni < 4; ++ni) acc[mi][ni] = __builtin_amdgcn_mfma_f32_16x16x32_bf16(bfr[ni], af[mi], acc[mi][ni], 0, 0, 0);
        }
        if (more) {
            char* sw = smem + ((kt + 1) & 1) * STAGE;
#pragma unroll
            for (int i = 0; i < NA; ++i) *(uint4*)(sw + soff + i * 32 * 144) = ra[i];
#pragma unroll
            for (int i = 0; i < 4; ++i) *(uint4*)(sw + A_BYTES + soff + i * 32 * 144) = rb[i];
        }
        __syncthreads();
    }
}

template <int MT>
__device__ __forceinline__ void zero_acc(f32x4 (&acc)[MT][4]) {
#pragma unroll
    for (int mi = 0; mi < MT; ++mi)
#pragma unroll
        for (int ni = 0; ni < 4; ++ni) acc[mi][ni] = (f32x4){0.f, 0.f, 0.f, 0.f};
}
template <int MT, class F>
__device__ __forceinline__ void epi_foreach(f32x4 (&acc)[MT][4], int m0, int n0, F f) {
    const int lane = TIDX() & 63, wave = TIDX() >> 6, wr = wave >> 1, wc = wave & 1;
#pragma unroll
    for (int mi = 0; mi < MT; ++mi)
#pragma unroll
        for (int ni = 0; ni < 4; ++ni) f(m0 + wr * MT * 16 + mi * 16 + (lane & 15), n0 + wc * 64 + ni * 16 + (lane >> 4) * 4, acc[mi][ni]);
}

__device__ __forceinline__ void gemm_tile_bf16(const bf16_t* A, int lda, const bf16_t* Bt, int ldb, int K, bf16_t* C, int ldc, int m0, int n0, const float* bias, float scale, char* smem) {
    f32x4 acc[4][4];
    zero_acc<4>(acc);
    gemm_mainloop<4>(acc, A + (size_t)m0 * lda, lda, Bt + (size_t)n0 * ldb, ldb, K, smem);
    epi_foreach<4>(acc, m0, n0, [&](int row, int col, f32x4 v) {
        f32x4 bv = {0.f, 0.f, 0.f, 0.f};
        if (bias) bv = *(const f32x4*)(bias + col);
        v = v * scale + bv;
        *(uint2*)(C + (size_t)row * ldc + col) = pack4(v);
    });
}
__device__ __forceinline__ void gemm_tile_resid(const bf16_t* A, int lda, const bf16_t* Bt, int ldb, int K, float* out, int m0, int n0, char* smem) {
    f32x4 acc[4][4];
    zero_acc<4>(acc);
    gemm_mainloop<4>(acc, A + (size_t)m0 * lda, lda, Bt + (size_t)n0 * ldb, ldb, K, smem);
    epi_foreach<4>(acc, m0, n0, [&](int row, int col, f32x4 v) {
        f32x4* o = (f32x4*)(out + (size_t)row * DM + col);
        f32x4 h = *o;
        *o = h * DN_ALPHA + v;
    });
}

__device__ void conv_w_tile(const CJob& j, int tile, char* smem) {
    float* ts = (float*)smem;
    const int ktiles = j.K >> 6;
    const int nt = tile / ktiles, kt = tile - nt * ktiles;
    const int n0 = nt * 64, k0 = kt * 64;
    const int tid = TIDX();
    const int nn = tid & 63;
    const int n = n0 + nn;
    int col;
    if (j.mode == 0) col = n;
    else if (j.mode == 1) col = n < 3088 ? n : (n < 3200 ? -1 : n - 112);
    else {
        const int t = n >> 7, r = n & 127, wc = r >> 6, ni = (r >> 4) & 3, c = r & 15;
        col = (ni < 2) ? (t * 64 + wc * 32 + ni * 16 + c) : (DFF + t * 64 + wc * 32 + (ni - 2) * 16 + c);
    }
#pragma unroll
    for (int i = 0; i < 16; ++i) {
        const int kk = (tid >> 6) + i * 4;
        ts[kk * 65 + nn] = col >= 0 ? j.src[(size_t)(k0 + kk) * j.ld + col] : 0.f;
    }
    __syncthreads();
    const int wn = tid >> 2, kg = tid & 3;
    unsigned pk[8];
#pragma unroll
    for (int e = 0; e < 8; ++e) pk[e] = cvt_pk_bf16(ts[(kg * 16 + 2 * e) * 65 + wn], ts[(kg * 16 + 2 * e + 1) * 65 + wn]);
    uint4* d = (uint4*)(j.dst + (size_t)(n0 + wn) * j.K + k0 + kg * 16);
    d[0] = make_uint4(pk[0], pk[1], pk[2], pk[3]);
    d[1] = make_uint4(pk[4], pk[5], pk[6], pk[7]);
    __syncthreads();
}
__device__ void conv_w_set(const CJob* jobs, int njobs, int tile, char* smem) {
    int prev = 0;
    for (int i = 0; i < njobs; ++i) {
        const int e = jobs[i].tile_end;
        if (tile < e) { conv_w_tile(jobs[i], tile - prev, smem); return; }
        prev = e;
    }
}

__device__ void ln_rows(const float* src, float* dst, bf16_t* hb, const float* g, const float* bta, int item) {
    const int lane = TIDX() & 63, wave = TIDX() >> 6;
    const int row = item * 4 + wave;
    const float4* s4 = (const float4*)(src + (size_t)row * DM);
    float4 v[4];
    float s = 0.f;
#pragma unroll
    for (int i = 0; i < 4; ++i) { v[i] = s4[lane + i * 64]; s += v[i].x + v[i].y + v[i].z + v[i].w; }
    const float mu = wave_sum(s) * (1.f / DM);
    float q = 0.f;
#pragma unroll
    for (int i = 0; i < 4; ++i) { float a = v[i].x - mu, b = v[i].y - mu, c = v[i].z - mu, d = v[i].w - mu; q += a * a + b * b + c * c + d * d; }
    const float rs = rsqrtf(wave_sum(q) * (1.f / DM) + LN_EPS);
#pragma unroll
    for (int i = 0; i < 4; ++i) {
        const int c4 = lane + i * 64;
        const float4 gg = ((const float4*)g)[c4], bb = ((const float4*)bta)[c4];
        float4 y;
        y.x = (v[i].x - mu) * rs * gg.x + bb.x; y.y = (v[i].y - mu) * rs * gg.y + bb.y;
        y.z = (v[i].z - mu) * rs * gg.z + bb.z; y.w = (v[i].w - mu) * rs * gg.w + bb.w;
        ((float4*)(dst + (size_t)row * DM))[c4] = y;
        uint2 pkd; pkd.x = cvt_pk_bf16(y.x, y.y); pkd.y = cvt_pk_bf16(y.z, y.w);
        ((uint2*)(hb + (size_t)row * DM))[c4] = pkd;
    }
}

__device__ void dwconv_item(const Params& p, int L, int item) {
    const int id = item * 256 + TIDX();
    const int tok = id >> 6, c0 = (id & 63) * 8;
    const int pos = tok & (SEQ - 1);
    const bf16_t* R3 = (const bf16_t*)(p.ws + OFF_R3);
    const float* w = p.in[6] + L * 4 * 512;
    const float* cb = p.in[7] + L * 512;
    float accv[8];
#pragma unroll
    for (int e = 0; e < 8; ++e) accv[e] = cb[c0 + e];
#pragma unroll
    for (int k = 0; k < 4; ++k) {
        const int d = 3 - k;
        if (pos >= d) {
            const uint4 u = *(const uint4*)(R3 + (size_t)(tok - d) * PROJ_LD + C_ULRU + c0);
            const float* wk = w + k * 512 + c0;
            accv[0] += wk[0] * lo_bf(u.x); accv[1] += wk[1] * hi_bf(u.x);
            accv[2] += wk[2] * lo_bf(u.y); accv[3] += wk[3] * hi_bf(u.y);
            accv[4] += wk[4] * lo_bf(u.z); accv[5] += wk[5] * hi_bf(u.z);
            accv[6] += wk[6] * lo_bf(u.w); accv[7] += wk[7] * hi_bf(u.w);
        }
    }
    uint4 o;
    o.x = cvt_pk_bf16(accv[0], accv[1]); o.y = cvt_pk_bf16(accv[2], accv[3]);
    o.z = cvt_pk_bf16(accv[4], accv[5]); o.w = cvt_pk_bf16(accv[6], accv[7]);
    *(uint4*)((bf16_t*)(p.ws + OFF_UC) + (size_t)tok * 512 + c0) = o;
}

__device__ void lru_pass(const Params& p, int L, int item, int pass) {
    const int id = item * 256 + TIDX();
    const int c = id & 511, bn = id >> 9;
    const size_t t0 = (size_t)bn * 64;
    const bf16_t* uc = (const bf16_t*)(p.ws + OFF_UC) + t0 * 512 + c;
    const bf16_t* gl = (const bf16_t*)(p.ws + OFF_GL) + t0 * 1024 + (c >> 7) * 256 + (c & 127);
    bf16_t* R3 = (bf16_t*)(p.ws + OFF_R3) + t0 * PROJ_LD;
    float* cP = (float*)(p.ws + OFF_LRUP);
    float* cH = (float*)(p.ws + OFF_LRUH);
    const float lam = p.in[12][L * 512 + c];
    const float sp8 = -8.f * log1pf(expf(-lam));
    float P = 1.f, H = 0.f;
    if (pass == 3) H = cP[id];
#pragma unroll 4
    for (int s = 0; s < 64; ++s) {
        const float rl = bf2f(gl[(size_t)s * 1024]);
        const float il = bf2f(gl[(size_t)s * 1024 + 128]);
        const float u = bf2f(uc[(size_t)s * 512]);
        const float la = sp8 * sigmoid_(rl);
        const float a = __expf(la);
        const float mult = sqrtf(-expm1f(2.f * la));
        const float bt = mult * sigmoid_(il) * u;
        H = a * H + bt;
        if (pass == 1) P *= a;
        else {
            const float gv = bf2f(R3[(size_t)s * PROJ_LD + C_GLRU + c]);
            R3[(size_t)s * PROJ_LD + C_ULRU + c] = f2bf(H * gelu_t(gv));
        }
    }
    if (pass == 1) { cP[id] = P; cH[id] = H; }
}
__device__ void lru_scan(const Params& p, int item) {
    const int id = item * 256 + TIDX();
    const int c = id & 511, b = id >> 9;
    float* cP = (float*)(p.ws + OFF_LRUP);
    const float* cH = (const float*)(p.ws + OFF_LRUH);
    float H = 0.f;
    for (int n = 0; n < 64; ++n) {
        const int ix = (b * 64 + n) * 512 + c;
        const float Pn = cP[ix], Hn = cH[ix];
        cP[ix] = H;
        H = Pn * H + Hn;
    }
}

__device__ void s5_item(const Params& p, int L, int item, int pass, char* smem) {
    const int tid = TIDX(), lane = tid & 63, wave = tid >> 6;
    const int g = (item & 7) * 4 + wave, bn = item >> 3;
    const size_t t0 = (size_t)bn * 64;
    char* wsm = smem + wave * (4096 + 16 * 272);
    float* us = (float*)wsm;
    bf16_t* xs = (bf16_t*)(wsm + 4096);
    bf16_t* R3 = (bf16_t*)(p.ws + OFF_R3) + t0 * PROJ_LD + C_US5 + g * 16;
    const int sp = (L * 32 + g) * 64 + lane;
    const float dt = expf(p.in[18][L * 32 + g]);
    const float lre = p.in[16][sp], lim = p.in[17][sp];
    const float th = lim * dt;
    const float sn = sinf(th), cs = cosf(th);
    const float em1 = expm1f(lre * dt);
    const float ar = (em1 + 1.f) * cs, ai = (em1 + 1.f) * sn;
    const float shh = sinf(0.5f * th);
    const float arm1 = em1 * cs - 2.f * shh * shh;
    const float den = lre * lre + lim * lim;
    const float fre = (arm1 * lre + ai * lim) / den, fim = (ai * lre - arm1 * lim) / den;
    float bbr[16], bbi[16];
    {
        const float4* br4 = (const float4*)(p.in[19] + (size_t)sp * 16);
        const float4* bi4 = (const float4*)(p.in[20] + (size_t)sp * 16);
#pragma unroll
        for (int i = 0; i < 4; ++i) {
            const float4 r = br4[i], m = bi4[i];
            bbr[4 * i + 0] = fre * r.x - fim * m.x; bbi[4 * i + 0] = fre * m.x + fim * r.x;
            bbr[4 * i + 1] = fre * r.y - fim * m.y; bbi[4 * i + 1] = fre * m.y + fim * r.y;
            bbr[4 * i + 2] = fre * r.z - fim * m.z; bbi[4 * i + 2] = fre * m.z + fim * r.z;
            bbr[4 * i + 3] = fre * r.w - fim * m.w; bbi[4 * i + 3] = fre * m.w + fim * r.w;
        }
    }
    {
        const uint4 a = *(const uint4*)(R3 + (size_t)lane * PROJ_LD);
        const uint4 b = *(const uint4*)(R3 + (size_t)lane * PROJ_LD + 8);
        float4* d = (float4*)(us + lane * 16);
        d[0] = make_float4(lo_bf(a.x), hi_bf(a.x), lo_bf(a.y), hi_bf(a.y));
        d[1] = make_float4(lo_bf(a.z), hi_bf(a.z), lo_bf(a.w), hi_bf(a.w));
        d[2] = make_float4(lo_bf(b.x), hi_bf(b.x), lo_bf(b.y), hi_bf(b.y));
        d[3] = make_float4(lo_bf(b.z), hi_bf(b.z), lo_bf(b.w), hi_bf(b.w));
    }
    float2* carry = (float2*)(p.ws + OFF_S5C) + ((size_t)bn * 32 + g) * 64 + lane;
    float xr = 0.f, xi = 0.f;
    bf16x8 cf[4];
    if (pass == 3) {
        const float2 c0 = *carry;
        xr = c0.x; xi = c0.y;
        const int ci = lane & 15, kq = (lane >> 4) * 8;
        const float* cre = p.in[21] + ((size_t)(L * 32 + g) * 16 + ci) * 64;
        const float* cim = p.in[22] + ((size_t)(L * 32 + g) * 16 + ci) * 64;
#pragma unroll
        for (int ks = 0; ks < 4; ++ks) {
            const float* s = (ks < 2 ? cre : cim) + (ks & 1) * 32 + kq;
            const float sg = ks < 2 ? 1.f : -1.f;
            const float4 a = *(const float4*)s, b = *(const float4*)(s + 4);
            union { bf16x8 v; unsigned u[4]; } t;
            t.u[0] = cvt_pk_bf16(sg * a.x, sg * a.y); t.u[1] = cvt_pk_bf16(sg * a.z, sg * a.w);
            t.u[2] = cvt_pk_bf16(sg * b.x, sg * b.y); t.u[3] = cvt_pk_bf16(sg * b.z, sg * b.w);
            cf[ks] = t.v;
        }
    }
    __syncthreads();
    for (int j = 0; j < 4; ++j) {
#pragma unroll 4
        for (int s = 0; s < 16; ++s) {
            const float4* u4 = (const float4*)(us + (j * 16 + s) * 16);
            float bre = 0.f, bim = 0.f;
#pragma unroll
            for (int i = 0; i < 4; ++i) {
                const float4 u = u4[i];
                bre += bbr[4 * i] * u.x + bbr[4 * i + 1] * u.y + bbr[4 * i + 2] * u.z + bbr[4 * i + 3] * u.w;
                bim += bbi[4 * i] * u.x + bbi[4 * i + 1] * u.y + bbi[4 * i + 2] * u.z + bbi[4 * i + 3] * u.w;
            }
            const float nr = ar * xr - ai * xi + bre;
            const float ni = ar * xi + ai * xr + bim;
            xr = nr; xi = ni;
            if (pass == 3) { xs[s * 136 + lane] = f2bf(xr); xs[s * 136 + 64 + lane] = f2bf(xi); }
        }
        if (pass == 3) {
            f32x4 acc = {0.f, 0.f, 0.f, 0.f};
#pragma unroll
            for (int ks = 0; ks < 4; ++ks) {
                const bf16x8 af = *(const bf16x8*)(xs + (lane & 15) * 136 + ks * 32 + (lane >> 4) * 8);
                acc = __builtin_amdgcn_mfma_f32_16x16x32_bf16(cf[ks], af, acc, 0, 0, 0);
            }
            const int sa = j * 16 + (lane & 15), i0 = (lane >> 4) * 4;
            const float4 uu = *(const float4*)(us + sa * 16 + i0);
            const float4 dd = *(const float4*)(p.in[23] + L * 512 + g * 16 + i0);
            f32x4 z;
            z[0] = gelu_t(acc[0] + dd.x * uu.x); z[1] = gelu_t(acc[1] + dd.y * uu.y);
            z[2] = gelu_t(acc[2] + dd.z * uu.z); z[3] = gelu_t(acc[3] + dd.w * uu.w);
            *(uint2*)(R3 + (size_t)sa * PROJ_LD + i0) = pack4(z);
        }
    }
    if (pass == 1) *carry = make_float2(xr, xi);
    __syncthreads();
}
__device__ void s5_scan(const Params& p, int L, int item) {
    const int id = item * 256 + TIDX();
    const int pg = id & 2047, b = id >> 11;
    const int g = pg >> 6;
    const float dt = expf(p.in[18][L * 32 + g]);
    const float lre = p.in[16][L * 2048 + pg], lim = p.in[17][L * 2048 + pg];
    const float th = lim * dt;
    const float mag = expf(lre * dt);
    float ar = mag * cosf(th), ai = mag * sinf(th);
#pragma unroll
    for (int i = 0; i < 6; ++i) { const float r = ar * ar - ai * ai, m = 2.f * ar * ai; ar = r; ai = m; }
    float2* carry = (float2*)(p.ws + OFF_S5C);
    float xr = 0.f, xi = 0.f;
    for (int n = 0; n < 64; ++n) {
        float2* cptr = carry + ((size_t)(b * 64 + n)) * 2048 + pg;
        const float2 l = *cptr;
        *cptr = make_float2(xr, xi);
        const float nr = ar * xr - ai * xi + l.x;
        const float ni = ar * xi + ai * xr + l.y;
        xr = nr; xi = ni;
    }
}

__device__ void gla_item(const Params& p, int L, int item, int pass, char* smem) {
    const int tid = TIDX(), lane = tid & 63, wave = tid >> 6;
    const int n = item & 63, bh = item >> 6, h = bh & 3, b = bh >> 2;
    const size_t t0 = (size_t)b * SEQ + n * 64;
    bf16_t* pr = (bf16_t*)(p.ws + OFF_R3) + t0 * PROJ_LD;
    float* lrs = (float*)smem;
    float* tot = (float*)(smem + 4096);
    bf16_t* qd = (bf16_t*)(smem + 5120);
    bf16_t* ki = (bf16_t*)(smem + 5120 + 9216);
    bf16_t* vT = (bf16_t*)(smem + 5120 + 18432);
    bf16_t* att = (bf16_t*)(smem + 5120 + 36864);
    bf16_t* ST = (bf16_t*)(smem + 5120 + 46080);
    float* dsT = (float*)(p.ws + OFF_R5) + (size_t)item * 8192;
    if (tid < 128) {
        const int s = tid >> 1, hf = tid & 1;
        const uint4 a = *(const uint4*)(pr + (size_t)s * PROJ_LD + C_LR + hf * 8);
        float4* d = (float4*)(lrs + s * 16 + hf * 8);
        d[0] = make_float4(lo_bf(a.x), hi_bf(a.x), lo_bf(a.y), hi_bf(a.y));
        d[1] = make_float4(lo_bf(a.z), hi_bf(a.z), lo_bf(a.w), hi_bf(a.w));
    }
    {
        const int vv = tid & 127, sh = tid >> 7;
#pragma unroll 8
        for (int j = 0; j < 32; ++j) {
            const int s = sh * 32 + j;
            vT[vv * 72 + s] = pr[(size_t)s * PROJ_LD + C_V + h * 128 + vv];
        }
    }
    if (pass == 3) {
#pragma unroll 8
        for (int i = 0; i < 32; ++i) {
            const int idx = tid + i * 256;
            ST[(idx >> 6) * 72 + (idx & 63)] = f2bf(dsT[idx]);
        }
    }
    __syncthreads();
    {
        const int kk = lane, sg = wave;
        const int col = h * 64 + kk;
        float wl[16];
#pragma unroll
        for (int r = 0; r < 16; ++r) wl[r] = p.in[13][(size_t)L * 16 * 256 + r * 256 + col];
        const float bl = p.in[14][L * 256 + col];
        float bcum[16];
        float run = 0.f;
#pragma unroll
        for (int j = 0; j < 16; ++j) {
            const float4* l4 = (const float4*)(lrs + (sg * 16 + j) * 16);
            float lg = bl;
#pragma unroll
            for (int i = 0; i < 4; ++i) { const float4 x = l4[i]; lg += x.x * wl[4 * i] + x.y * wl[4 * i + 1] + x.z * wl[4 * i + 2] + x.w * wl[4 * i + 3]; }
            run += logsigmoid_(lg) * (1.f / 16.f);
            bcum[j] = run;
        }
        tot[sg * 64 + kk] = run;
        __syncthreads();
        float off = 0.f, blast = 0.f;
#pragma unroll
        for (int gi = 0; gi < 4; ++gi) { const float t = tot[gi * 64 + kk]; blast += t; if (gi < sg) off += t; }
#pragma unroll
        for (int j = 0; j < 16; ++j) {
            const int s = sg * 16 + j;
            const float bv = bcum[j] + off;
            const float kv = bf2f(pr[(size_t)s * PROJ_LD + C_K + col]);
            if (pass == 3) {
                const float qv = bf2f(pr[(size_t)s * PROJ_LD + C_Q + col]);
                qd[s * 72 + kk] = f2bf(qv * 0.125f * __expf(bv));
                ki[s * 72 + kk] = f2bf(kv * __expf(-bv));
            } else {
                ki[kk * 72 + s] = f2bf(kv * __expf(blast - bv));
            }
        }
        if (pass == 1 && sg == 0) ((float*)(p.ws + OFF_DEC))[item * 64 + kk] = __expf(blast);
    }
    __syncthreads();
    const int fr = lane & 15, fq = lane >> 4;
    if (pass == 1) {
        f32x4 acc[2][4];
#pragma unroll
        for (int mi = 0; mi < 2; ++mi)
#pragma unroll
            for (int ni = 0; ni < 4; ++ni) acc[mi][ni] = (f32x4){0.f, 0.f, 0.f, 0.f};
#pragma unroll
        for (int ks = 0; ks < 2; ++ks) {
            bf16x8 af[2], bfr[4];
#pragma unroll
            for (int mi = 0; mi < 2; ++mi) af[mi] = *(const bf16x8*)(vT + (wave * 32 + mi * 16 + fr) * 72 + ks * 32 + fq * 8);
#pragma unroll
            for (int ni = 0; ni < 4; ++ni) bfr[ni] = *(const bf16x8*)(ki + (ni * 16 + fr) * 72 + ks * 32 + fq * 8);
#pragma unroll
            for (int mi = 0; mi < 2; ++mi)
#pragma unroll
                for (int ni = 0; ni < 4; ++ni) acc[mi][ni] = __builtin_amdgcn_mfma_f32_16x16x32_bf16(bfr[ni], af[mi], acc[mi][ni], 0, 0, 0);
        }
#pragma unroll
        for (int mi = 0; mi < 2; ++mi)
#pragma unroll
            for (int ni = 0; ni < 4; ++ni) *(f32x4*)(dsT + (wave * 32 + mi * 16 + fr) * 64 + ni * 16 + fq * 4) = acc[mi][ni];
    } else {
        const int c = wave * 16 + fr;
        {
            f32x4 aa[4];
#pragma unroll
            for (int ni = 0; ni < 4; ++ni) aa[ni] = (f32x4){0.f, 0.f, 0.f, 0.f};
#pragma unroll
            for (int ks = 0; ks < 2; ++ks) {
                const bf16x8 af = *(const bf16x8*)(qd + c * 72 + ks * 32 + fq * 8);
#pragma unroll
                for (int ni = 0; ni < 4; ++ni) {
                    const bf16x8 bfr = *(const bf16x8*)(ki + (ni * 16 + fr) * 72 + ks * 32 + fq * 8);
                    aa[ni] = __builtin_amdgcn_mfma_f32_16x16x32_bf16(bfr, af, aa[ni], 0, 0, 0);
                }
            }
#pragma unroll
            for (int ni = 0; ni < 4; ++ni) {
                const int s0 = ni * 16 + fq * 4;
                f32x4 v = aa[ni];
#pragma unroll
                for (int r = 0; r < 4; ++r) if (s0 + r > c) v[r] = 0.f;
                *(uint2*)(att + c * 72 + s0) = pack4(v);
            }
        }
        __syncthreads();
        f32x4 ao[8];
#pragma unroll
        for (int ni = 0; ni < 8; ++ni) ao[ni] = (f32x4){0.f, 0.f, 0.f, 0.f};
#pragma unroll
        for (int ks = 0; ks < 2; ++ks) {
            const bf16x8 af = *(const bf16x8*)(att + c * 72 + ks * 32 + fq * 8);
#pragma unroll
            for (int ni = 0; ni < 8; ++ni) {
                const bf16x8 bfr = *(const bf16x8*)(vT + (ni * 16 + fr) * 72 + ks * 32 + fq * 8);
                ao[ni] = __builtin_amdgcn_mfma_f32_16x16x32_bf16(bfr, af, ao[ni], 0, 0, 0);
            }
        }
#pragma unroll
        for (int ks = 0; ks < 2; ++ks) {
            const bf16x8 af = *(const bf16x8*)(qd + c * 72 + ks * 32 + fq * 8);
#pragma unroll
            for (int ni = 0; ni < 8; ++ni) {
                const bf16x8 bfr = *(const bf16x8*)(ST + (ni * 16 + fr) * 72 + ks * 32 + fq * 8);
                ao[ni] = __builtin_amdgcn_mfma_f32_16x16x32_bf16(bfr, af, ao[ni], 0, 0, 0);
            }
        }
        float ss = 0.f;
#pragma unroll
        for (int ni = 0; ni < 8; ++ni) ss += ao[ni][0] * ao[ni][0] + ao[ni][1] * ao[ni][1] + ao[ni][2] * ao[ni][2] + ao[ni][3] * ao[ni][3];
        ss += __shfl_xor(ss, 16);
        ss += __shfl_xor(ss, 32);
        const float rinv = rsqrtf(ss * (1.f / 128.f) + LN_EPS);
        const float* ng = p.in[15] + L * 128;
#pragma unroll
        for (int ni = 0; ni < 8; ++ni) {
            const int v0 = ni * 16 + fq * 4;
            bf16_t* op = pr + (size_t)c * PROJ_LD + C_OG + h * 128 + v0;
            const uint2 ogp = *(const uint2*)op;
            const float4 gg = *(const float4*)(ng + v0);
            f32x4 y;
            float o0 = lo_bf(ogp.x), o1 = hi_bf(ogp.x), o2 = lo_bf(ogp.y), o3 = hi_bf(ogp.y);
            y[0] = ao[ni][0] * rinv * gg.x * (o0 * sigmoid_(o0));
            y[1] = ao[ni][1] * rinv * gg.y * (o1 * sigmoid_(o1));
            y[2] = ao[ni][2] * rinv * gg.z * (o2 * sigmoid_(o2));
            y[3] = ao[ni][3] * rinv * gg.w * (o3 * sigmoid_(o3));
            *(uint2*)op = pack4(y);
        }
    }
    __syncthreads();
}
__device__ void gla_scan(const Params& p, int item) {
    const int id = item * 256 + TIDX();
    const int e = id & 8191, bh = id >> 13, kk = e & 63;
    float* dsT = (float*)(p.ws + OFF_R5) + (size_t)bh * 64 * 8192 + e;
    const float* dec = (const float*)(p.ws + OFF_DEC) + (size_t)bh * 64 * 64 + kk;
    float S = 0.f;
#pragma unroll 4
    for (int n = 0; n < 64; ++n) {
        const float d = dsT[(size_t)n * 8192];
        dsT[(size_t)n * 8192] = S;
        S = dec[n * 64] * S + d;
    }
}

__device__ void softmax_item(const Params& p, int item) {
    const int lane = TIDX() & 63, wave = TIDX() >> 6;
    bf16_t* S = (bf16_t*)(p.ws + OFF_XS);
#pragma unroll
    for (int r = 0; r < 4; ++r) {
        const size_t row = (size_t)item * 16 + wave * 4 + r;
        uint2* ptr = (uint2*)(S + row * 256) + lane;
        const uint2 v = *ptr;
        float a = lo_bf(v.x), b = hi_bf(v.x), c = lo_bf(v.y), d = hi_bf(v.y);
        const float mx = wave_max(fmaxf(fmaxf(a, b), fmaxf(c, d)));
        a = __expf(a - mx); b = __expf(b - mx); c = __expf(c - mx); d = __expf(d - mx);
        const float inv = 1.f / wave_sum(a + b + c + d);
        uint2 o; o.x = cvt_pk_bf16(a * inv, b * inv); o.y = cvt_pk_bf16(c * inv, d * inv);
        *ptr = o;
    }
}

constexpr int PH_PER_LAYER = 18, N_PHASES = 1 + 2 * PH_PER_LAYER;

__device__ void run_phase(const Params& p, int ph, char* smem) {
    const int G = gridDim.x, B = blockIdx.x;
    char* ws = p.ws;
    bf16_t* hb = (bf16_t*)(ws + OFF_HB);
    if (ph == 0) {
        const int nconv = p.wa[0][NWA - 1].tile_end;
        const int nmem = 1024 * 1024 / (256 * 8);
        const int nln = NTOK / 4;
        for (int it = B; it < nconv + nmem + nln; it += G) {
            if (it < nconv) conv_w_set(p.wa[0], NWA, it, smem);
            else if (it < nconv + nmem) {
                const size_t i8 = ((size_t)(it - nconv) * 256 + TIDX()) * 8;
                const float4 a = *(const float4*)(p.in[1] + i8), b = *(const float4*)(p.in[1] + i8 + 4);
                uint4 o; o.x = cvt_pk_bf16(a.x, a.y); o.y = cvt_pk_bf16(a.z, a.w); o.z = cvt_pk_bf16(b.x, b.y); o.w = cvt_pk_bf16(b.z, b.w);
                *(uint4*)((bf16_t*)(ws + OFF_MEMB) + i8) = o;
            } else ln_rows(p.in[0], p.out, hb, p.in[2], p.in[3], it - nconv - nmem);
        }
        return;
    }
    const int L = (ph - 1) / PH_PER_LAYER, q = (ph - 1) % PH_PER_LAYER;
    bf16_t* R3 = (bf16_t*)(ws + OFF_R3);
    switch (q) {
    case 0: {
        const bf16_t* Wt = (const bf16_t*)(ws + WT_IN);
        const float* bias = p.in[5] + (size_t)L * 6160;
        for (int it = B; it < 128 * 25; it += G) {
            const int mt = it / 25, nt = it % 25;
            const int m0 = mt * 128, n0 = nt * 128;
            f32x4 acc[4][4];
            zero_acc<4>(acc);
            gemm_mainloop<4>(acc, hb + (size_t)m0 * DM, DM, Wt + (size_t)n0 * DM, DM, DM, smem);
            epi_foreach<4>(acc, m0, n0, [&](int row, int col, f32x4 v) {
                if (col < 3088) { v = v + *(const f32x4*)(bias + col); }
                *(uint2*)(R3 + (size_t)row * PROJ_LD + col) = pack4(v);
            });
        }
    } break;
    case 1: {
        const int n1 = 1024, n2 = 2048, n3 = 4096;
        for (int it = B; it < n1 + n2 + n3; it += G) {
            if (it < n1) gla_item(p, L, it, 1, smem);
            else if (it < n1 + n2) s5_item(p, L, it - n1, 1, smem);
            else dwconv_item(p, L, it - n1 - n2);
        }
    } break;
    case 2: {
        const int n1 = 128 * 2 * 4, n2 = 512, n3 = 32;
        const bf16_t* uc = (const bf16_t*)(ws + OFF_UC);
        const bf16_t* Wl = (const bf16_t*)(ws + WT_LRU);
        bf16_t* gl = (bf16_t*)(ws + OFF_GL);
        for (int it = B; it < n1 + n2 + n3; it += G) {
            if (it < n1) {
                const int z = it & 3, nt = (it >> 2) & 1, mt = it >> 3;
                const float* bias = (nt == 0 ? p.in[9] : p.in[11]) + L * 512 + z * 128 - nt * 128;
                gemm_tile_bf16(uc + z * 128, 512, Wl + (size_t)z * 256 * 128, 128, 128, gl + z * 256, 1024, mt * 128, nt * 128, bias, 1.f, smem);
            } else if (it < n1 + n2) gla_scan(p, it - n1);
            else s5_scan(p, L, it - n1 - n2);
        }
    } break;
    case 3: {
        const int n1 = 1024, n2 = 2048, n3 = 512;
        for (int it = B; it < n1 + n2 + n3; it += G) {
            if (it < n1) gla_item(p, L, it, 3, smem);
            else if (it < n1 + n2) s5_item(p, L, it - n1, 3, smem);
            else lru_pass(p, L, it - n1 - n2, 1);
        }
    } break;
    case 4: {
        const int n1 = 128 * 4, n2 = 8;
        const bf16_t* Wg = (const bf16_t*)(ws + WT_GLU);
        bf16_t* yc = R3 + C_Q;
        const float* bias = p.in[25] + L * 512;
        for (int it = B; it < n1 + n2; it += G) {
            if (it < n1) {
                const int mt = it >> 2, nt = it & 3;
                const int m0 = mt * 128, n0 = nt * 128;
                f32x4 acc[4][4];
                zero_acc<4>(acc);
                gemm_mainloop<4>(acc, R3 + (size_t)m0 * PROJ_LD + C_US5, PROJ_LD, Wg + (size_t)n0 * 512, 512, 512, smem);
                epi_foreach<4>(acc, m0, n0, [&](int row, int col, f32x4 v) {
                    const f32x4 bv = *(const f32x4*)(bias + col);
                    const uint2 zz = *(const uint2*)(R3 + (size_t)row * PROJ_LD + C_US5 + col);
                    f32x4 y;
                    y[0] = lo_bf(zz.x) * sigmoid_(v[0] + bv[0]); y[1] = hi_bf(zz.x) * sigmoid_(v[1] + bv[1]);
                    y[2] = lo_bf(zz.y) * sigmoid_(v[2] + bv[2]); y[3] = hi_bf(zz.y) * sigmoid_(v[3] + bv[3]);
                    *(uint2*)(yc + (size_t)row * PROJ_LD + col) = pack4(y);
                });
            } else lru_scan(p, it - n1);
        }
    } break;
    case 5: {
        for (int it = B; it < 512; it += G) lru_pass(p, L, it, 3);
    } break;
    case 6: {
        const bf16_t* Wt = (const bf16_t*)(ws + WT_IN);
        const bf16_t* Wb = (const bf16_t*)(ws + WT_BR);
        const float* bias = p.in[5] + (size_t)L * 6160 + 3088;
        bf16_t* mg = (bf16_t*)(ws + OFF_R5);
        for (int it = B; it < 256 * 8; it += G) {
            const int mt = it >> 3, nt = it & 7;
            const int m0 = mt * 64, n0 = nt * 128;
            f32x4 m[2][4];
            zero_acc<2>(m);
#pragma unroll 1
            for (int n = 0; n < 3; ++n) {
                f32x4 ag[2][4], ab[2][4];
                zero_acc<2>(ag);
                gemm_mainloop<2>(ag, hb + (size_t)m0 * DM, DM, Wt + (size_t)(3200 + n * 1024 + n0) * DM, DM, DM, smem);
                const bf16_t* yA = (n == 0) ? (R3 + C_ULRU) : (n == 1 ? (R3 + C_OG) : (R3 + C_Q));
                const int ldy = PROJ_LD;
                zero_acc<2>(ab);
                gemm_mainloop<2>(ab, yA + (size_t)m0 * ldy, ldy, Wb + (size_t)(n * 1024 + n0) * 512, 512, 512, smem);
                const int lane = TIDX() & 63, wc = (TIDX() >> 6) & 1;
#pragma unroll
                for (int mi = 0; mi < 2; ++mi)
#pragma unroll
                    for (int ni = 0; ni < 4; ++ni) {
                        const int col = n0 + wc * 64 + ni * 16 + (lane >> 4) * 4;
                        const f32x4 bv = *(const f32x4*)(bias + n * 1024 + col);
#pragma unroll
                        for (int r = 0; r < 4; ++r) m[mi][ni][r] += sigmoid_(ag[mi][ni][r] + bv[r]) * ab[mi][ni][r];
                    }
            }
            epi_foreach<2>(m, m0, n0, [&](int row, int col, f32x4 v) { *(uint2*)(mg + (size_t)row * DM + col) = pack4(v); });
        }
    } break;
    case 7: {
        const bf16_t* mg = (const bf16_t*)(ws + OFF_R5);
        const bf16_t* Wm = (const bf16_t*)(ws + WT_MIX);
        for (int it = B; it < 128 * 8; it += G) gemm_tile_resid(mg, DM, Wm, DM, DM, p.out, (it >> 3) * 128, (it & 7) * 128, smem);
    } break;
    case 8: {
        const int n1 = NTOK / 4, n2 = p.wb[L][NWB - 1].tile_end;
        for (int it = B; it < n1 + n2; it += G) {
            if (it < n1) ln_rows(p.out, p.out, hb, p.in[28] + L * DM, p.in[29] + L * DM, it);
            else conv_w_set(p.wb[L], NWB, it - n1, smem);
        }
    } break;
    case 9: {
        const int n1 = 128 * 8, n2 = 8 * 8, n3 = 4 * 8 * 2;
        const bf16_t* Wq = (const bf16_t*)(ws + WT_Q);
        const bf16_t* Wkv = (const bf16_t*)(ws + WT_KV);
        const bf16_t* memb = (const bf16_t*)(ws + OFF_MEMB);
        for (int it = B; it < n1 + n2 + n3; it += G) {
            if (it < n1) gemm_tile_bf16(hb, DM, Wq, DM, DM, (bf16_t*)(ws + OFF_XQ), DM, (it >> 3) * 128, (it & 7) * 128, nullptr, 0.0625f, smem);
            else if (it < n1 + n2) { const int t = it - n1; gemm_tile_bf16(memb, DM, Wkv, DM, DM, (bf16_t*)(ws + OFF_KB), DM, (t >> 3) * 128, (t & 7) * 128, nullptr, 1.f, smem); }
            else {
                const int t = it - n1 - n2; const int b = t >> 4, mt = (t >> 1) & 7, nt = t & 1;
                gemm_tile_bf16(Wkv + (size_t)1024 * DM, DM, memb + (size_t)b * 256 * DM, DM, DM, (bf16_t*)(ws + OFF_VT) + (size_t)b * 1024 * 256, 256, mt * 128, nt * 128, nullptr, 1.f, smem);
            }
        }
    } break;
    case 10: {
        for (int it = B; it < 16 * 32 * 2; it += G) {
            const int nt = it & 1, mt = (it >> 1) & 31, z = it >> 6, b = z >> 2, h = z & 3;
            gemm_tile_bf16((const bf16_t*)(ws + OFF_XQ) + (size_t)b * SEQ * DM + h * 256, DM, (const bf16_t*)(ws + OFF_KB) + (size_t)b * 256 * DM + h * 256, DM, 256,
                           (bf16_t*)(ws + OFF_XS) + (size_t)z * SEQ * 256, 256, mt * 128, nt * 128, nullptr, 1.f, smem);
        }
    } break;
    case 11: {
        for (int it = B; it < 4096; it += G) softmax_item(p, it);
    } break;
    case 12: {
        for (int it = B; it < 16 * 32 * 2; it += G) {
            const int nt = it & 1, mt = (it >> 1) & 31, z = it >> 6, b = z >> 2, h = z & 3;
            gemm_tile_bf16((const bf16_t*)(ws + OFF_XS) + (size_t)z * SEQ * 256, 256, (const bf16_t*)(ws + OFF_VT) + (size_t)b * 1024 * 256 + (size_t)h * 256 * 256, 256, 256,
                           (bf16_t*)(ws + OFF_XO) + (size_t)b * SEQ * DM + h * 256, DM, mt * 128, nt * 128, nullptr, 1.f, smem);
        }
    } break;
    case 13: {
        for (int it = B; it < 128 * 8; it += G) gemm_tile_resid((const bf16_t*)(ws + OFF_XO), DM, (const bf16_t*)(ws + WT_O), DM, DM, p.out, (it >> 3) * 128, (it & 7) * 128, smem);
    } break;
    case 14: {
        const int n1 = NTOK / 4, n2 = (L + 1 < 2) ? p.wa[1][NWA - 1].tile_end : 0;
        for (int it = B; it < n1 + n2; it += G) {
            if (it < n1) ln_rows(p.out, p.out, hb, p.in[33] + L * DM, p.in[34] + L * DM, it);
            else conv_w_set(p.wa[1], NWA, it - n1, smem);
        }
    } break;
    case 15: {
        const bf16_t* Wgu = (const bf16_t*)(ws + WT_GU);
        bf16_t* act = (bf16_t*)(ws + OFF_ACT);
        for (int it = B; it < 128 * 44; it += G) {
            const int mt = it / 44, nt = it % 44;
            const int m0 = mt * 128;
            f32x4 acc[4][4];
            zero_acc<4>(acc);
            gemm_mainloop<4>(acc, hb + (size_t)m0 * DM, DM, Wgu + (size_t)nt * 128 * DM, DM, DM, smem);
            const int lane = TIDX() & 63, wave = TIDX() >> 6, wr = wave >> 1, wc = wave & 1;
#pragma unroll
            for (int mi = 0; mi < 4; ++mi)
#pragma unroll
                for (int ni = 0; ni < 2; ++ni) {
                    const int row = m0 + wr * 64 + mi * 16 + (lane & 15);
                    const int col = nt * 64 + wc * 32 + ni * 16 + (lane >> 4) * 4;
                    f32x4 y;
#pragma unroll
                    for (int r = 0; r < 4; ++r) { const float gte = acc[mi][ni][r]; y[r] = gte * sigmoid_(gte) * acc[mi][ni + 2][r]; }
                    *(uint2*)(act + (size_t)row * DFF + col) = pack4(y);
                }
        }
    } break;
    case 16: {
        for (int it = B; it < 128 * 8; it += G) gemm_tile_resid((const bf16_t*)(ws + OFF_ACT), DFF, (const bf16_t*)(ws + WT_DN), DFF, DFF, p.out, (it >> 3) * 128, (it & 7) * 128, smem);
    } break;
    case 17: {
        for (int it = B; it < NTOK / 4; it += G) ln_rows(p.out, p.out, hb, p.in[37] + L * DM, p.in[38] + L * DM, it);
    } break;
    }
}

__global__ void __launch_bounds__(256, 2) fwd_megakernel(Params p) {
    extern __shared__ __attribute__((aligned(16))) char smem[];
    cg::grid_group grid = cg::this_grid();
    for (int ph = p.ph_lo; ph < p.ph_hi; ++ph) {
        run_phase(p, ph, smem);
        if (ph + 1 < p.ph_hi) grid.sync();
    }
}

static void add_job(CJob* jobs, int& n, int& tiles, const float* src, bf16_t* dst, int ld, int K, int nrows, int mode) {
    tiles += (nrows / 64) * (K / 64);
    jobs[n].src = src; jobs[n].dst = dst; jobs[n].ld = ld; jobs[n].K = K; jobs[n].mode = mode; jobs[n].tile_end = tiles;
    ++n;
}

extern "C" void kernel_launch(void* const* d_in, const int* in_sizes, int n_in, void* d_out, int out_size, void* d_ws, size_t ws_size, hipStream_t stream) {
    static int grid_blocks = 0;
    if (grid_blocks == 0) {
        if (n_in != 39 || ws_size < WS_END) { fprintf(stderr, "kernel_launch: unexpected n_in %d or ws_size %zu (< %zu)\n", n_in, ws_size, (size_t)WS_END); grid_blocks = -1; return; }
        int dev = 0, cus = 0, per_cu = 0;
        hipGetDevice(&dev);
        hipDeviceGetAttribute(&cus, hipDeviceAttributeMultiprocessorCount, dev);
        if (hipFuncSetAttribute((const void*)fwd_megakernel, hipFuncAttributeMaxDynamicSharedMemorySize, SMEM_BYTES) != hipSuccess) { fprintf(stderr, "hipFuncSetAttribute failed\n"); grid_blocks = -1; return; }
        if (hipOccupancyMaxActiveBlocksPerMultiprocessor(&per_cu, (const void*)fwd_megakernel, 256, SMEM_BYTES) != hipSuccess || per_cu < 1) { fprintf(stderr, "occupancy query failed\n"); grid_blocks = -1; return; }
        if (per_cu > 2) per_cu = 2;
        grid_blocks = cus * per_cu;
    }
    if (grid_blocks < 0) return;
    Params p{};
    for (int i = 0; i < 39; ++i) p.in[i] = (const float*)d_in[i];
    p.out = (float*)d_out;
    p.ws = (char*)d_ws;
    char* ws = (char*)d_ws;
    for (int L = 0; L < 2; ++L) {
        int n = 0, t = 0;
        add_job(p.wa[L], n, t, p.in[4] + (size_t)L * 1024 * 6160, (bf16_t*)(ws + WT_IN), 6160, 1024, 6272, 1);
        for (int h = 0; h < 4; ++h) {
            add_job(p.wa[L], n, t, p.in[8] + (size_t)(L * 4 + h) * 128 * 128, (bf16_t*)(ws + WT_LRU) + (size_t)h * 256 * 128, 128, 128, 128, 0);
            add_job(p.wa[L], n, t, p.in[10] + (size_t)(L * 4 + h) * 128 * 128, (bf16_t*)(ws + WT_LRU) + (size_t)h * 256 * 128 + 128 * 128, 128, 128, 128, 0);
        }
        add_job(p.wa[L], n, t, p.in[24] + (size_t)L * 512 * 512, (bf16_t*)(ws + WT_GLU), 512, 512, 512, 0);
        for (int b = 0; b < 3; ++b) add_job(p.wa[L], n, t, p.in[26] + (size_t)(L * 3 + b) * 512 * 1024, (bf16_t*)(ws + WT_BR) + (size_t)b * 1024 * 512, 1024, 512, 1024, 0);
        add_job(p.wa[L], n, t, p.in[27] + (size_t)L * 1024 * 1024, (bf16_t*)(ws + WT_MIX), 1024, 1024, 1024, 0);
        n = 0; t = 0;
        add_job(p.wb[L], n, t, p.in[30] + (size_t)L * 1024 * 1024, (bf16_t*)(ws + WT_Q), 1024, 1024, 1024, 0);
        add_job(p.wb[L], n, t, p.in[31] + (size_t)L * 1024 * 2048, (bf16_t*)(ws + WT_KV), 2048, 1024, 2048, 0);
        add_job(p.wb[L], n, t, p.in[32] + (size_t)L * 1024 * 1024, (bf16_t*)(ws + WT_O), 1024, 1024, 1024, 0);
        add_job(p.wb[L], n, t, p.in[35] + (size_t)L * 1024 * 5632, (bf16_t*)(ws + WT_GU), 5632, 1024, 5632, 2);
        add_job(p.wb[L], n, t, p.in[36] + (size_t)L * 2816 * 1024, (bf16_t*)(ws + WT_DN), 1024, 2816, 1024, 0);
    }
#if SINGLE_LAUNCH
    p.ph_lo = 0; p.ph_hi = N_PHASES;
    void* args[] = {&p};
    hipError_t e = hipLaunchCooperativeKernel((const void*)fwd_megakernel, dim3(grid_blocks), dim3(256), args, SMEM_BYTES, stream);
    if (e != hipSuccess) fprintf(stderr, "cooperative launch failed: %s (grid %d)\n", hipGetErrorString(e), grid_blocks);
#else
    for (int ph = 0; ph < N_PHASES; ++ph) {
        p.ph_lo = ph; p.ph_hi = ph + 1;
        hipLaunchKernelGGL(fwd_megakernel, dim3(grid_blocks), dim3(256), SMEM_BYTES, stream, p);
    }
#endif
}
```

```cpp
#include <hip/hip_runtime.h>
#include <hip/hip_cooperative_groups.h>
#include <cstdio>
namespace cg = cooperative_groups;

#ifndef SINGLE_LAUNCH
#define SINGLE_LAUNCH 1
#endif

typedef unsigned short bf16_t;
typedef short bf16x8 __attribute__((ext_vector_type(8)));
typedef float f32x4 __attribute__((ext_vector_type(4)));

constexpr int NTOK = 16384, DM = 1024, SEQ = 4096, NB = 4;
constexpr int PROJ_LD = 3200;
constexpr int C_ULRU = 0, C_GLRU = 512, C_Q = 1024, C_K = 1280, C_V = 1536, C_OG = 2048, C_LR = 2560, C_US5 = 2576;
constexpr int DFF = 2816;
constexpr float DN_ALPHA = 1.4142135623730951f;
constexpr float LN_EPS = 1e-5f;

constexpr size_t WT_IN = 0;
constexpr size_t WT_LRU = WT_IN + 6272ull * 1024 * 2;
constexpr size_t WT_GLU = WT_LRU + 4ull * 256 * 128 * 2;
constexpr size_t WT_BR = WT_GLU + 512ull * 512 * 2;
constexpr size_t WT_MIX = WT_BR + 3ull * 1024 * 512 * 2;
constexpr size_t OFF_HB = WT_MIX + 1024ull * 1024 * 2;
constexpr size_t OFF_MEMB = OFF_HB + 16384ull * 1024 * 2;
constexpr size_t OFF_R3 = OFF_MEMB + 1024ull * 1024 * 2;
constexpr size_t OFF_R4 = OFF_R3 + 16384ull * 3200 * 2;
constexpr size_t OFF_UC = OFF_R4;
constexpr size_t OFF_GL = OFF_R4 + 16384ull * 512 * 2;
constexpr size_t OFF_R5 = OFF_GL + 16384ull * 1024 * 2;
constexpr size_t OFF_S5C = OFF_R5 + 1024ull * 8192 * 4;
constexpr size_t OFF_LRUP = OFF_S5C + 4ull * 64 * 32 * 64 * 8;
constexpr size_t OFF_LRUH = OFF_LRUP + 4ull * 64 * 512 * 4;
constexpr size_t OFF_DEC = OFF_LRUH + 4ull * 64 * 512 * 4;
constexpr size_t OFF_KB = OFF_DEC + 1024ull * 64 * 4;
constexpr size_t OFF_VT = OFF_KB + 1024ull * 1024 * 2;
constexpr size_t OFF_BAR = OFF_VT + 4ull * 1024 * 256 * 2;
constexpr size_t WS_END = OFF_BAR + 3456 * 4;
constexpr size_t WT_Q = OFF_GL;
constexpr size_t WT_KV = WT_Q + 1024ull * 1024 * 2;
constexpr size_t WT_O = WT_KV + 2048ull * 1024 * 2;
constexpr size_t WT_GU = WT_O + 1024ull * 1024 * 2;
constexpr size_t WT_DN = WT_GU + 5632ull * 1024 * 2;
static_assert(WT_DN + 1024ull * 2816 * 2 <= OFF_R5, "wb overflow");
constexpr size_t OFF_XQ = OFF_R3;
constexpr size_t OFF_XS = OFF_R3 + 16384ull * 1024 * 2;
constexpr size_t OFF_XO = OFF_XS + 16384ull * 1024 * 2;
constexpr size_t OFF_ACT = OFF_R3;

constexpr int SMEM_BYTES = 2 * (256 * 144);

struct CJob { const float* src; bf16_t* dst; int ld, K, mode, tile_end; };
constexpr int NWA = 14, NWB = 5;
struct Params {
    const float* in[39];
    float* out;
    char* ws;
    CJob wa[2][NWA];
    CJob wb[2][NWB];
    int ph_lo, ph_hi;
};

__device__ __forceinline__ int TIDX() { int t = threadIdx.x; asm volatile("" : "+v"(t)); return t; }
__device__ __forceinline__ float bf2f(bf16_t b) { return __uint_as_float(((unsigned)b) << 16); }
__device__ __forceinline__ unsigned cvt_pk_bf16(float lo, float hi) { unsigned r; asm volatile("v_cvt_pk_bf16_f32 %0, %1, %2" : "=v"(r) : "v"(lo), "v"(hi)); return r; }
__device__ __forceinline__ bf16_t f2bf(float f) { return (bf16_t)(cvt_pk_bf16(f, 0.f) & 0xffffu); }
__device__ __forceinline__ float lo_bf(unsigned u) { return __uint_as_float(u << 16); }
__device__ __forceinline__ float hi_bf(unsigned u) { return __uint_as_float(u & 0xffff0000u); }
__device__ __forceinline__ float sigmoid_(float x) { return 1.f / (1.f + __expf(-x)); }
__device__ __forceinline__ float gelu_t(float x) { float u = 1.5957691216057308f * (x + 0.044715f * x * x * x); return x / (1.f + __expf(-u)); }
__device__ __forceinline__ float logsigmoid_(float x) { return fminf(x, 0.f) - log1pf(__expf(-fabsf(x))); }
__device__ __forceinline__ uint2 pack4(f32x4 v) { uint2 r; r.x = cvt_pk_bf16(v[0], v[1]); r.y = cvt_pk_bf16(v[2], v[3]); return r; }
__device__ __forceinline__ float wave_sum(float v) {
#pragma unroll
    for (int o = 32; o > 0; o >>= 1) v += __shfl_xor(v, o);
    return v;
}
__device__ __forceinline__ float wave_max(float v) {
#pragma unroll
    for (int o = 32; o > 0; o >>= 1) v = fmaxf(v, __shfl_xor(v, o));
    return v;
}

template <int MT>
__device__ __forceinline__ void gemm_mainloop(f32x4 (&acc)[MT][4], const bf16_t* __restrict__ A, int lda, const bf16_t* __restrict__ Bt, int ldb, int K, char* smem) {
    constexpr int BM = MT * 32;
    constexpr int A_BYTES = BM * 144, STAGE = A_BYTES + 128 * 144;
    constexpr int NA = MT;
    const int tid = TIDX(), lane = tid & 63, wave = tid >> 6, wr = wave >> 1, wc = wave & 1;
    const int prow = tid >> 3, pc = tid & 7;
    const bf16_t* ag = A + (size_t)prow * lda + pc * 8;
    const bf16_t* bg = Bt + (size_t)prow * ldb + pc * 8;
    const int soff = prow * 144 + pc * 16;
    const int fa = (wr * MT * 16 + (lane & 15)) * 144 + (lane >> 4) * 16;
    const int fb = A_BYTES + (wc * 64 + (lane & 15)) * 144 + (lane >> 4) * 16;
    uint4 ra[NA], rb[4];
    const int nk = K >> 6;
#pragma unroll
    for (int i = 0; i < NA; ++i) ra[i] = *(const uint4*)(ag + (size_t)(i * 32) * lda);
#pragma unroll
    for (int i = 0; i < 4; ++i) rb[i] = *(const uint4*)(bg + (size_t)(i * 32) * ldb);
#pragma unroll
    for (int i = 0; i < NA; ++i) *(uint4*)(smem + soff + i * 32 * 144) = ra[i];
#pragma unroll
    for (int i = 0; i < 4; ++i) *(uint4*)(smem + A_BYTES + soff + i * 32 * 144) = rb[i];
    __syncthreads();
    for (int kt = 0; kt < nk; ++kt) {
        const bool more = (kt + 1 < nk);
        if (more) {
#pragma unroll
            for (int i = 0; i < NA; ++i) ra[i] = *(const uint4*)(ag + (size_t)(i * 32) * lda + (kt + 1) * 64);
#pragma unroll
            for (int i = 0; i < 4; ++i) rb[i] = *(const uint4*)(bg + (size_t)(i * 32) * ldb + (kt + 1) * 64);
        }
        const char* st = smem + (kt & 1) * STAGE;
#pragma unroll
        for (int ks = 0; ks < 2; ++ks) {
            bf16x8 af[MT], bfr[4];
#pragma unroll
            for (int mi = 0; mi < MT; ++mi) af[mi] = *(const bf16x8*)(st + fa + mi * 16 * 144 + ks * 64);
#pragma unroll
            for (int ni = 0; ni < 4; ++ni) bfr[ni] = *(const bf16x8*)(st + fb + ni * 16 * 144 + ks * 64);
#pragma unroll
            for (int mi = 0; mi < MT; ++mi)
#pragma unroll
                for (int ni = 0; ni < 4; ++ni) acc[mi][ni] = __builtin_amdgcn_mfma_f32_16x16x32_bf16(bfr[ni], af[mi], acc[mi][ni], 0, 0, 0);
        }
        if (more) {
            char* sw = smem + ((kt + 1) & 1) * STAGE;
#pragma unroll
            for (int i = 0; i < NA; ++i) *(uint4*)(sw + soff + i * 32 * 144) = ra[i];
#pragma unroll
            for (int i = 0; i < 4; ++i) *(uint4*)(sw + A_BYTES + soff + i * 32 * 144) = rb[i];
        }
        __syncthreads();
    }
}

template <int MT>
__device__ __forceinline__ void zero_acc(f32x4 (&acc)[MT][4]) {
#pragma unroll
    for (int mi = 0; mi < MT; ++mi)
#pragma unroll
        for (int ni = 0; ni < 4; ++ni) acc[mi][ni] = (f32x4){0.f, 0.f, 0.f, 0.f};
}
template <int MT, class F>
__device__ __forceinline__ void epi_foreach(f32x4 (&acc)[MT][4], int m0, int n0, F f) {
    const int lane = TIDX() & 63, wave = TIDX() >> 6, wr = wave >> 1, wc = wave & 1;
#pragma unroll
    for (int mi = 0; mi < MT; ++mi)
#pragma unroll
        for (int ni = 0; ni < 4; ++ni) f(m0 + wr * MT * 16 + mi * 16 + (lane & 15), n0 + wc * 64 + ni * 16 + (lane >> 4) * 4, acc[mi][ni]);
}

__device__ __forceinline__ void gemm_tile_bf16(const bf16_t* A, int lda, const bf16_t* Bt, int ldb, int K, bf16_t* C, int ldc, int m0, int n0, const float* bias, float scale, char* smem) {
    f32x4 acc[4][4];
    zero_acc<4>(acc);
    gemm_mainloop<4>(acc, A + (size_t)m0 * lda, lda, Bt + (size_t)n0 * ldb, ldb, K, smem);
    epi_foreach<4>(acc, m0, n0, [&](int row, int col, f32x4 v) {
        f32x4 bv = {0.f, 0.f, 0.f, 0.f};
        if (bias) bv = *(const f32x4*)(bias + col);
        v = v * scale + bv;
        *(uint2*)(C + (size_t)row * ldc + col) = pack4(v);
    });
}
__device__ __forceinline__ void gemm_tile_resid(const bf16_t* A, int lda, const bf16_t* Bt, int ldb, int K, float* out, int m0, int n0, char* smem) {
    f32x4 acc[4][4];
    zero_acc<4>(acc);
    gemm_mainloop<4>(acc, A + (size_t)m0 * lda, lda, Bt + (size_t)n0 * ldb, ldb, K, smem);
    epi_foreach<4>(acc, m0, n0, [&](int row, int col, f32x4 v) {
        f32x4* o = (f32x4*)(out + (size_t)row * DM + col);
        f32x4 h = *o;
        *o = h * DN_ALPHA + v;
    });
}

__device__ void conv_w_tile(const CJob& j, int tile, char* smem) {
    float* ts = (float*)smem;
    const int ktiles = j.K >> 6;
    const int nt = tile / ktiles, kt = tile - nt * ktiles;
    const int n0 = nt * 64, k0 = kt * 64;
    const int tid = TIDX();
    const int nn = tid & 63;
    const int n = n0 + nn;
    int col;
    if (j.mode == 0) col = n;
    else if (j.mode == 1) col = n < 3088 ? n : (n < 3200 ? -1 : n - 112);
    else {
        const int t = n >> 7, r = n & 127, wc = r >> 6, ni = (r >> 4) & 3, c = r & 15;
        col = (ni < 2) ? (t * 64 + wc * 32 + ni * 16 + c) : (DFF + t * 64 + wc * 32 + (ni - 2) * 16 + c);
    }
#pragma unroll
    for (int i = 0; i < 16; ++i) {
        const int kk = (tid >> 6) + i * 4;
        ts[kk * 65 + nn] = col >= 0 ? j.src[(size_t)(k0 + kk) * j.ld + col] : 0.f;
    }
    __syncthreads();
    const int wn = tid >> 2, kg = tid & 3;
    unsigned pk[8];
#pragma unroll
    for (int e = 0; e < 8; ++e) pk[e] = cvt_pk_bf16(ts[(kg * 16 + 2 * e) * 65 + wn], ts[(kg * 16 + 2 * e + 1) * 65 + wn]);
    uint4* d = (uint4*)(j.dst + (size_t)(n0 + wn) * j.K + k0 + kg * 16);
    d[0] = make_uint4(pk[0], pk[1], pk[2], pk[3]);
    d[1] = make_uint4(pk[4], pk[5], pk[6], pk[7]);
    __syncthreads();
}
__device__ void conv_w_set(const CJob* jobs, int njobs, int tile, char* smem) {
    int prev = 0;
    for (int i = 0; i < njobs; ++i) {
        const int e = jobs[i].tile_end;
        if (tile < e) { conv_w_tile(jobs[i], tile - prev, smem); return; }
        prev = e;
    }
}

__device__ void ln_rows(const float* src, float* dst, bf16_t* hb, const float* g, const float* bta, int item) {
    const int lane = TIDX() & 63, wave = TIDX() >> 6;
    const int row = item * 4 + wave;
    const float4* s4 = (const float4*)(src + (size_t)row * DM);
    float4 v[4];
    float s = 0.f;
#pragma unroll
    for (int i = 0; i < 4; ++i) { v[i] = s4[lane + i * 64]; s += v[i].x + v[i].y + v[i].z + v[i].w; }
    const float mu = wave_sum(s) * (1.f / DM);
    float q = 0.f;
#pragma unroll
    for (int i = 0; i < 4; ++i) { float a = v[i].x - mu, b = v[i].y - mu, c = v[i].z - mu, d = v[i].w - mu; q += a * a + b * b + c * c + d * d; }
    const float rs = rsqrtf(wave_sum(q) * (1.f / DM) + LN_EPS);
#pragma unroll
    for (int i = 0; i < 4; ++i) {
        const int c4 = lane + i * 64;
        const float4 gg = ((const float4*)g)[c4], bb = ((const float4*)bta)[c4];
        float4 y;
        y.x = (v[i].x - mu) * rs * gg.x + bb.x; y.y = (v[i].y - mu) * rs * gg.y + bb.y;
        y.z = (v[i].z - mu) * rs * gg.z + bb.z; y.w = (v[i].w - mu) * rs * gg.w + bb.w;
        ((float4*)(dst + (size_t)row * DM))[c4] = y;
        uint2 pkd; pkd.x = cvt_pk_bf16(y.x, y.y); pkd.y = cvt_pk_bf16(y.z, y.w);
        ((uint2*)(hb + (size_t)row * DM))[c4] = pkd;
    }
}

__device__ void dwconv_item(const Params& p, int L, int item) {
    const int id = item * 256 + TIDX();
    const int tok = id >> 6, c0 = (id & 63) * 8;
    const int pos = tok & (SEQ - 1);
    const bf16_t* R3 = (const bf16_t*)(p.ws + OFF_R3);
    const float* w = p.in[6] + L * 4 * 512;
    const float* cb = p.in[7] + L * 512;
    float accv[8];
#pragma unroll
    for (int e = 0; e < 8; ++e) accv[e] = cb[c0 + e];
#pragma unroll
    for (int k = 0; k < 4; ++k) {
        const int d = 3 - k;
        if (pos >= d) {
            const uint4 u = *(const uint4*)(R3 + (size_t)(tok - d) * PROJ_LD + C_ULRU + c0);
            const float* wk = w + k * 512 + c0;
            accv[0] += wk[0] * lo_bf(u.x); accv[1] += wk[1] * hi_bf(u.x);
            accv[2] += wk[2] * lo_bf(u.y); accv[3] += wk[3] * hi_bf(u.y);
            accv[4] += wk[4] * lo_bf(u.z); accv[5] += wk[5] * hi_bf(u.z);
            accv[6] += wk[6] * lo_bf(u.w); accv[7] += wk[7] * hi_bf(u.w);
        }
    }
    uint4 o;
    o.x = cvt_pk_bf16(accv[0], accv[1]); o.y = cvt_pk_bf16(accv[2], accv[3]);
    o.z = cvt_pk_bf16(accv[4], accv[5]); o.w = cvt_pk_bf16(accv[6], accv[7]);
    *(uint4*)((bf16_t*)(p.ws + OFF_UC) + (size_t)tok * 512 + c0) = o;
}

__device__ void lru_pass(const Params& p, int L, int item, int pass) {
    const int id = item * 256 + TIDX();
    const int c = id & 511, bn = id >> 9;
    const size_t t0 = (size_t)bn * 64;
    const bf16_t* uc = (const bf16_t*)(p.ws + OFF_UC) + t0 * 512 + c;
    const bf16_t* gl = (const bf16_t*)(p.ws + OFF_GL) + t0 * 1024 + (c >> 7) * 256 + (c & 127);
    bf16_t* R3 = (bf16_t*)(p.ws + OFF_R3) + t0 * PROJ_LD;
    float* cP = (float*)(p.ws + OFF_LRUP);
    float* cH = (float*)(p.ws + OFF_LRUH);
    const float lam = p.in[12][L * 512 + c];
    const float sp8 = -8.f * log1pf(expf(-lam));
    float P = 1.f, H = 0.f;
    if (pass == 3) H = cP[id];
#pragma unroll 4
    for (int s = 0; s < 64; ++s) {
        const float rl = bf2f(gl[(size_t)s * 1024]);
        const float il = bf2f(gl[(size_t)s * 1024 + 128]);
        const float u = bf2f(uc[(size_t)s * 512]);
        const float la = sp8 * sigmoid_(rl);
        const float a = __expf(la);
        const float mult = sqrtf(-expm1f(2.f * la));
        const float bt = mult * sigmoid_(il) * u;
        H = a * H + bt;
        if (pass == 1) P *= a;
        else {
            const float gv = bf2f(R3[(size_t)s * PROJ_LD + C_GLRU + c]);
            R3[(size_t)s * PROJ_LD + C_ULRU + c] = f2bf(H * gelu_t(gv));
        }
    }
    if (pass == 1) { cP[id] = P; cH[id] = H; }
}
__device__ void lru_scan(const Params& p, int item) {
    const int id = item * 256 + TIDX();
    const int c = id & 511, b = id >> 9;
    float* cP = (float*)(p.ws + OFF_LRUP);
    const float* cH = (const float*)(p.ws + OFF_LRUH);
    float H = 0.f;
    for (int n = 0; n < 64; ++n) {
        const int ix = (b * 64 + n) * 512 + c;
        const float Pn = cP[ix], Hn = cH[ix];
        cP[ix] = H;
        H = Pn * H + Hn;
    }
}

__device__ void s5_item(const Params& p, int L, int item, int pass, char* smem) {
    const int tid = TIDX(), lane = tid & 63, wave = tid >> 6;
    const int g = (item & 7) * 4 + wave, bn = item >> 3;
    const size_t t0 = (size_t)bn * 64;
    char* wsm = smem + wave * (4096 + 16 * 272);
    float* us = (float*)wsm;
    bf16_t* xs = (bf16_t*)(wsm + 4096);
    bf16_t* R3 = (bf16_t*)(p.ws + OFF_R3) + t0 * PROJ_LD + C_US5 + g * 16;
    const int sp = (L * 32 + g) * 64 + lane;
    const float dt = expf(p.in[18][L * 32 + g]);
    const float lre = p.in[16][sp], lim = p.in[17][sp];
    const float th = lim * dt;
    const float sn = sinf(th), cs = cosf(th);
    const float em1 = expm1f(lre * dt);
    const float ar = (em1 + 1.f) * cs, ai = (em1 + 1.f) * sn;
    const float shh = sinf(0.5f * th);
    const float arm1 = em1 * cs - 2.f * shh * shh;
    const float den = lre * lre + lim * lim;
    const float fre = (arm1 * lre + ai * lim) / den, fim = (ai * lre - arm1 * lim) / den;
    float bbr[16], bbi[16];
    {
        const float4* br4 = (const float4*)(p.in[19] + (size_t)sp * 16);
        const float4* bi4 = (const float4*)(p.in[20] + (size_t)sp * 16);
#pragma unroll
        for (int i = 0; i < 4; ++i) {
            const float4 r = br4[i], m = bi4[i];
            bbr[4 * i + 0] = fre * r.x - fim * m.x; bbi[4 * i + 0] = fre * m.x + fim * r.x;
            bbr[4 * i + 1] = fre * r.y - fim * m.y; bbi[4 * i + 1] = fre * m.y + fim * r.y;
            bbr[4 * i + 2] = fre * r.z - fim * m.z; bbi[4 * i + 2] = fre * m.z + fim * r.z;
            bbr[4 * i + 3] = fre * r.w - fim * m.w; bbi[4 * i + 3] = fre * m.w + fim * r.w;
        }
    }
    {
        const uint4 a = *(const uint4*)(R3 + (size_t)lane * PROJ_LD);
        const uint4 b = *(const uint4*)(R3 + (size_t)lane * PROJ_LD + 8);
        float4* d = (float4*)(us + lane * 16);
        d[0] = make_float4(lo_bf(a.x), hi_bf(a.x), lo_bf(a.y), hi_bf(a.y));
        d[1] = make_float4(lo_bf(a.z), hi_bf(a.z), lo_bf(a.w), hi_bf(a.w));
        d[2] = make_float4(lo_bf(b.x), hi_bf(b.x), lo_bf(b.y), hi_bf(b.y));
        d[3] = make_float4(lo_bf(b.z), hi_bf(b.z), lo_bf(b.w), hi_bf(b.w));
    }
    float2* carry = (float2*)(p.ws + OFF_S5C) + ((size_t)bn * 32 + g) * 64 + lane;
    float xr = 0.f, xi = 0.f;
    bf16x8 cf[4];
    if (pass == 3) {
        const float2 c0 = *carry;
        xr = c0.x; xi = c0.y;
        const int ci = lane & 15, kq = (lane >> 4) * 8;
        const float* cre = p.in[21] + ((size_t)(L * 32 + g) * 16 + ci) * 64;
        const float* cim = p.in[22] + ((size_t)(L * 32 + g) * 16 + ci) * 64;
#pragma unroll
        for (int ks = 0; ks < 4; ++ks) {
            const float* s = (ks < 2 ? cre : cim) + (ks & 1) * 32 + kq;
            const float sg = ks < 2 ? 1.f : -1.f;
            const float4 a = *(const float4*)s, b = *(const float4*)(s + 4);
            union { bf16x8 v; unsigned u[4]; } t;
            t.u[0] = cvt_pk_bf16(sg * a.x, sg * a.y); t.u[1] = cvt_pk_bf16(sg * a.z, sg * a.w);
            t.u[2] = cvt_pk_bf16(sg * b.x, sg * b.y); t.u[3] = cvt_pk_bf16(sg * b.z, sg * b.w);
            cf[ks] = t.v;
        }
    }
    __syncthreads();
    for (int j = 0; j < 4; ++j) {
#pragma unroll 4
        for (int s = 0; s < 16; ++s) {
            const float4* u4 = (const float4*)(us + (j * 16 + s) * 16);
            float bre = 0.f, bim = 0.f;
#pragma unroll
            for (int i = 0; i < 4; ++i) {
                const float4 u = u4[i];
                bre += bbr[4 * i] * u.x + bbr[4 * i + 1] * u.y + bbr[4 * i + 2] * u.z + bbr[4 * i + 3] * u.w;
                bim += bbi[4 * i] * u.x + bbi[4 * i + 1] * u.y + bbi[4 * i + 2] * u.z + bbi[4 * i + 3] * u.w;
            }
            const float nr = ar * xr - ai * xi + bre;
            const float ni = ar * xi + ai * xr + bim;
            xr = nr; xi = ni;
            if (pass == 3) { xs[s * 136 + lane] = f2bf(xr); xs[s * 136 + 64 + lane] = f2bf(xi); }
        }
        if (pass == 3) {
            f32x4 acc = {0.f, 0.f, 0.f, 0.f};
#pragma unroll
            for (int ks = 0; ks < 4; ++ks) {
                const bf16x8 af = *(const bf16x8*)(xs + (lane & 15) * 136 + ks * 32 + (lane >> 4) * 8);
                acc = __builtin_amdgcn_mfma_f32_16x16x32_bf16(cf[ks], af, acc, 0, 0, 0);
            }
            const int sa = j * 16 + (lane & 15), i0 = (lane >> 4) * 4;
            const float4 uu = *(const float4*)(us + sa * 16 + i0);
            const float4 dd = *(const float4*)(p.in[23] + L * 512 + g * 16 + i0);
            f32x4 z;
            z[0] = gelu_t(acc[0] + dd.x * uu.x); z[1] = gelu_t(acc[1] + dd.y * uu.y);
            z[2] = gelu_t(acc[2] + dd.z * uu.z); z[3] = gelu_t(acc[3] + dd.w * uu.w);
            *(uint2*)(R3 + (size_t)sa * PROJ_LD + i0) = pack4(z);
        }
    }
    if (pass == 1) *carry = make_float2(xr, xi);
    __syncthreads();
}
__device__ void s5_scan(const Params& p, int L, int item) {
    const int id = item * 256 + TIDX();
    const int pg = id & 2047, b = id >> 11;
    const int g = pg >> 6;
    const float dt = expf(p.in[18][L * 32 + g]);
    const float lre = p.in[16][L * 2048 + pg], lim = p.in[17][L * 2048 + pg];
    const float th = lim * dt;
    const float mag = expf(lre * dt);
    float ar = mag * cosf(th), ai = mag * sinf(th);
#pragma unroll
    for (int i = 0; i < 6; ++i) { const float r = ar * ar - ai * ai, m = 2.f * ar * ai; ar = r; ai = m; }
    float2* carry = (float2*)(p.ws + OFF_S5C);
    float xr = 0.f, xi = 0.f;
    for (int n = 0; n < 64; ++n) {
        float2* cptr = carry + ((size_t)(b * 64 + n)) * 2048 + pg;
        const float2 l = *cptr;
        *cptr = make_float2(xr, xi);
        const float nr = ar * xr - ai * xi + l.x;
        const float ni = ar * xi + ai * xr + l.y;
        xr = nr; xi = ni;
    }
}

__device__ void gla_item(const Params& p, int L, int item, int pass, char* smem) {
    const int tid = TIDX(), lane = tid & 63, wave = tid >> 6;
    const int n = item & 63, bh = item >> 6, h = bh & 3, b = bh >> 2;
    const size_t t0 = (size_t)b * SEQ + n * 64;
    bf16_t* pr = (bf16_t*)(p.ws + OFF_R3) + t0 * PROJ_LD;
    float* lrs = (float*)smem;
    float* tot = (float*)(smem + 4096);
    bf16_t* qd = (bf16_t*)(smem + 5120);
    bf16_t* ki = (bf16_t*)(smem + 5120 + 9216);
    bf16_t* vT = (bf16_t*)(smem + 5120 + 18432);
    bf16_t* att = (bf16_t*)(smem + 5120 + 36864);
    bf16_t* ST = (bf16_t*)(smem + 5120 + 46080);
    float* dsT = (float*)(p.ws + OFF_R5) + (size_t)item * 8192;
    if (tid < 128) {
        const int s = tid >> 1, hf = tid & 1;
        const uint4 a = *(const uint4*)(pr + (size_t)s * PROJ_LD + C_LR + hf * 8);
        float4* d = (float4*)(lrs + s * 16 + hf * 8);
        d[0] = make_float4(lo_bf(a.x), hi_bf(a.x), lo_bf(a.y), hi_bf(a.y));
        d[1] = make_float4(lo_bf(a.z), hi_bf(a.z), lo_bf(a.w), hi_bf(a.w));
    }
    {
        const int vv = tid & 127, sh = tid >> 7;
#pragma unroll 8
        for (int j = 0; j < 32; ++j) {
            const int s = sh * 32 + j;
            vT[vv * 72 + s] = pr[(size_t)s * PROJ_LD + C_V + h * 128 + vv];
        }
    }
    if (pass == 3) {
#pragma unroll 8
        for (int i = 0; i < 32; ++i) {
            const int idx = tid + i * 256;
            ST[(idx >> 6) * 72 + (idx & 63)] = f2bf(dsT[idx]);
        }
    }
    __syncthreads();
    {
        const int kk = lane, sg = wave;
        const int col = h * 64 + kk;
        float wl[16];
#pragma unroll
        for (int r = 0; r < 16; ++r) wl[r] = p.in[13][(size_t)L * 16 * 256 + r * 256 + col];
        const float bl = p.in[14][L * 256 + col];
        float bcum[16];
        float run = 0.f;
#pragma unroll
        for (int j = 0; j < 16; ++j) {
            const float4* l4 = (const float4*)(lrs + (sg * 16 + j) * 16);
            float lg = bl;
#pragma unroll
            for (int i = 0; i < 4; ++i) { const float4 x = l4[i]; lg += x.x * wl[4 * i] + x.y * wl[4 * i + 1] + x.z * wl[4 * i + 2] + x.w * wl[4 * i + 3]; }
            run += logsigmoid_(lg) * (1.f / 16.f);
            bcum[j] = run;
        }
        tot[sg * 64 + kk] = run;
        __syncthreads();
        float off = 0.f, blast = 0.f;
#pragma unroll
        for (int gi = 0; gi < 4; ++gi) { const float t = tot[gi * 64 + kk]; blast += t; if (gi < sg) off += t; }
#pragma unroll
        for (int j = 0; j < 16; ++j) {
            const int s = sg * 16 + j;
            const float bv = bcum[j] + off;
            const float kv = bf2f(pr[(size_t)s * PROJ_LD + C_K + col]);
            if (pass == 3) {
                const float qv = bf2f(pr[(size_t)s * PROJ_LD + C_Q + col]);
                qd[s * 72 + kk] = f2bf(qv * 0.125f * __expf(bv));
                ki[s * 72 + kk] = f2bf(kv * __expf(-bv));
            } else {
                ki[kk * 72 + s] = f2bf(kv * __expf(blast - bv));
            }
        }
        if (pass == 1 && sg == 0) ((float*)(p.ws + OFF_DEC))[item * 64 + kk] = __expf(blast);
    }
    __syncthreads();
    const int fr = lane & 15, fq = lane >> 4;
    if (pass == 1) {
        f32x4 acc[2][4];
#pragma unroll
        for (int mi = 0; mi < 2; ++mi)
#pragma unroll
            for (int ni = 0; ni < 4; ++ni) acc[mi][ni] = (f32x4){0.f, 0.f, 0.f, 0.f};
#pragma unroll
        for (int ks = 0; ks < 2; ++ks) {
            bf16x8 af[2], bfr[4];
#pragma unroll
            for (int mi = 0; mi < 2; ++mi) af[mi] = *(const bf16x8*)(vT + (wave * 32 + mi * 16 + fr) * 72 + ks * 32 + fq * 8);
#pragma unroll
            for (int ni = 0; ni < 4; ++ni) bfr[ni] = *(const bf16x8*)(ki + (ni * 16 + fr) * 72 + ks * 32 + fq * 8);
#pragma unroll
            for (int mi = 0; mi < 2; ++mi)
#pragma unroll
                for (int ni = 0; ni < 4; ++ni) acc[mi][ni] = __builtin_amdgcn_mfma_f32_16x16x32_bf16(bfr[ni], af[mi], acc[mi][ni], 0, 0, 0);
        }
#pragma unroll
        for (int mi = 0; mi < 2; ++mi)
#pragma unroll
            for (int ni = 0; ni < 4; ++ni) *(f32x4*)(dsT + (wave * 32 + mi * 16 + fr) * 64 + ni * 16 + fq * 4) = acc[mi][ni];
    } else {
        const int c = wave * 16 + fr;
        {
            f32x4 aa[4];
#pragma unroll
            for (int ni = 0; ni < 4; ++ni) aa[ni] = (f32x4){0.f, 0.f, 0.f, 0.f};
#pragma unroll
            for (int ks = 0; ks < 2; ++ks) {
                const bf16x8 af = *(const bf16x8*)(qd + c * 72 + ks * 32 + fq * 8);
#pragma unroll
                for (int ni = 0; ni < 4; ++ni) {
                    const bf16x8 bfr = *(const bf16x8*)(ki + (ni * 16 + fr) * 72 + ks * 32 + fq * 8);
                    aa[ni] = __builtin_amdgcn_mfma_f32_16x16x32_bf16(bfr, af, aa[ni], 0, 0, 0);
                }
            }
#pragma unroll
            for (int ni = 0; ni < 4; ++ni) {
                const int s0 = ni * 16 + fq * 4;
                f32x4 v = aa[ni];
#pragma unroll
                for (int r = 0; r < 4; ++r) if (s0 + r > c) v[r] = 0.f;
                *(uint2*)(att + c * 72 + s0) = pack4(v);
            }
        }
        __syncthreads();
        f32x4 ao[8];
#pragma unroll
        for (int ni = 0; ni < 8; ++ni) ao[ni] = (f32x4){0.f, 0.f, 0.f, 0.f};
#pragma unroll
        for (int ks = 0; ks < 2; ++ks) {
            const bf16x8 af = *(const bf16x8*)(att + c * 72 + ks * 32 + fq * 8);
#pragma unroll
            for (int ni = 0; ni < 8; ++ni) {
                const bf16x8 bfr = *(const bf16x8*)(vT + (ni * 16 + fr) * 72 + ks * 32 + fq * 8);
                ao[ni] = __builtin_amdgcn_mfma_f32_16x16x32_bf16(bfr, af, ao[ni], 0, 0, 0);
            }
        }
#pragma unroll
        for (int ks = 0; ks < 2; ++ks) {
            const bf16x8 af = *(const bf16x8*)(qd + c * 72 + ks * 32 + fq * 8);
#pragma unroll
            for (int ni = 0; ni < 8; ++ni) {
                const bf16x8 bfr = *(const bf16x8*)(ST + (ni * 16 + fr) * 72 + ks * 32 + fq * 8);
                ao[ni] = __builtin_amdgcn_mfma_f32_16x16x32_bf16(bfr, af, ao[ni], 0, 0, 0);
            }
        }
        float ss = 0.f;
#pragma unroll
        for (int ni = 0; ni < 8; ++ni) ss += ao[ni][0] * ao[ni][0] + ao[ni][1] * ao[ni][1] + ao[ni][2] * ao[ni][2] + ao[ni][3] * ao[ni][3];
        ss += __shfl_xor(ss, 16);
        ss += __shfl_xor(ss, 32);
        const float rinv = rsqrtf(ss * (1.f / 128.f) + LN_EPS);
        const float* ng = p.in[15] + L * 128;
#pragma unroll
        for (int ni = 0; ni < 8; ++ni) {
            const int v0 = ni * 16 + fq * 4;
            bf16_t* op = pr + (size_t)c * PROJ_LD + C_OG + h * 128 + v0;
            const uint2 ogp = *(const uint2*)op;
            const float4 gg = *(const float4*)(ng + v0);
            f32x4 y;
            float o0 = lo_bf(ogp.x), o1 = hi_bf(ogp.x), o2 = lo_bf(ogp.y), o3 = hi_bf(ogp.y);
            y[0] = ao[ni][0] * rinv * gg.x * (o0 * sigmoid_(o0));
            y[1] = ao[ni][1] * rinv * gg.y * (o1 * sigmoid_(o1));
            y[2] = ao[ni][2] * rinv * gg.z * (o2 * sigmoid_(o2));
            y[3] = ao[ni][3] * rinv * gg.w * (o3 * sigmoid_(o3));
            *(uint2*)op = pack4(y);
        }
    }
    __syncthreads();
}
__device__ void gla_scan(const Params& p, int item) {
    const int id = item * 256 + TIDX();
    const int e = id & 8191, bh = id >> 13, kk = e & 63;
    float* dsT = (float*)(p.ws + OFF_R5) + (size_t)bh * 64 * 8192 + e;
    const float* dec = (const float*)(p.ws + OFF_DEC) + (size_t)bh * 64 * 64 + kk;
    float S = 0.f;
#pragma unroll 4
    for (int n = 0; n < 64; ++n) {
        const float d = dsT[(size_t)n * 8192];
        dsT[(size_t)n * 8192] = S;
        S = dec[n * 64] * S + d;
    }
}

__device__ void softmax_item(const Params& p, int item) {
    const int lane = TIDX() & 63, wave = TIDX() >> 6;
    bf16_t* S = (bf16_t*)(p.ws + OFF_XS);
#pragma unroll
    for (int r = 0; r < 4; ++r) {
        const size_t row = (size_t)item * 16 + wave * 4 + r;
        uint2* ptr = (uint2*)(S + row * 256) + lane;
        const uint2 v = *ptr;
        float a = lo_bf(v.x), b = hi_bf(v.x), c = lo_bf(v.y), d = hi_bf(v.y);
        const float mx = wave_max(fmaxf(fmaxf(a, b), fmaxf(c, d)));
        a = __expf(a - mx); b = __expf(b - mx); c = __expf(c - mx); d = __expf(d - mx);
        const float inv = 1.f / wave_sum(a + b + c + d);
        uint2 o; o.x = cvt_pk_bf16(a * inv, b * inv); o.y = cvt_pk_bf16(c * inv, d * inv);
        *ptr = o;
    }
}

constexpr int PH_PER_LAYER = 18, N_PHASES = 1 + 2 * PH_PER_LAYER;

__device__ void run_phase(const Params& p, int ph, char* smem) {
    const int G = gridDim.x, B = blockIdx.x;
    char* ws = p.ws;
    bf16_t* hb = (bf16_t*)(ws + OFF_HB);
    if (ph == 0) {
        const int nconv = p.wa[0][NWA - 1].tile_end;
        const int nmem = 1024 * 1024 / (256 * 8);
        const int nln = NTOK / 4;
        for (int it = B; it < nconv + nmem + nln; it += G) {
            if (it < nconv) conv_w_set(p.wa[0], NWA, it, smem);
            else if (it < nconv + nmem) {
                const size_t i8 = ((size_t)(it - nconv) * 256 + TIDX()) * 8;
                const float4 a = *(const float4*)(p.in[1] + i8), b = *(const float4*)(p.in[1] + i8 + 4);
                uint4 o; o.x = cvt_pk_bf16(a.x, a.y); o.y = cvt_pk_bf16(a.z, a.w); o.z = cvt_pk_bf16(b.x, b.y); o.w = cvt_pk_bf16(b.z, b.w);
                *(uint4*)((bf16_t*)(ws + OFF_MEMB) + i8) = o;
            } else ln_rows(p.in[0], p.out, hb, p.in[2], p.in[3], it - nconv - nmem);
        }
        return;
    }
    const int L = (ph - 1) / PH_PER_LAYER, q = (ph - 1) % PH_PER_LAYER;
    bf16_t* R3 = (bf16_t*)(ws + OFF_R3);
    switch (q) {
    case 0: {
        const bf16_t* Wt = (const bf16_t*)(ws + WT_IN);
        const float* bias = p.in[5] + (size_t)L * 6160;
        for (int it = B; it < 128 * 25; it += G) {
            const int mt = it / 25, nt = it % 25;
            const int m0 = mt * 128, n0 = nt * 128;
            f32x4 acc[4][4];
            zero_acc<4>(acc);
            gemm_mainloop<4>(acc, hb + (size_t)m0 * DM, DM, Wt + (size_t)n0 * DM, DM, DM, smem);
            epi_foreach<4>(acc, m0, n0, [&](int row, int col, f32x4 v) {
                if (col < 3088) { v = v + *(const f32x4*)(bias + col); }
                *(uint2*)(R3 + (size_t)row * PROJ_LD + col) = pack4(v);
            });
        }
    } break;
    case 1: {
        const int n1 = 1024, n2 = 2048, n3 = 4096;
        for (int it = B; it < n1 + n2 + n3; it += G) {
            if (it < n1) gla_item(p, L, it, 1, smem);
            else if (it < n1 + n2) s5_item(p, L, it - n1, 1, smem);
            else dwconv_item(p, L, it - n1 - n2);
        }
    } break;
    case 2: {
        const int n1 = 128 * 2 * 4, n2 = 512, n3 = 32;
        const bf16_t* uc = (const bf16_t*)(ws + OFF_UC);
        const bf16_t* Wl = (const bf16_t*)(ws + WT_LRU);
        bf16_t* gl = (bf16_t*)(ws + OFF_GL);
        for (int it = B; it < n1 + n2 + n3; it += G) {
            if (it < n1) {
                const int z = it & 3, nt = (it >> 2) & 1, mt = it >> 3;
                const float* bias = (nt == 0 ? p.in[9] : p.in[11]) + L * 512 + z * 128 - nt * 128;
                gemm_tile_bf16(uc + z * 128, 512, Wl + (size_t)z * 256 * 128, 128, 128, gl + z * 256, 1024, mt * 128, nt * 128, bias, 1.f, smem);
            } else if (it < n1 + n2) gla_scan(p, it - n1);
            else s5_scan(p, L, it - n1 - n2);
        }
    } break;
    case 3: {
        const int n1 = 1024, n2 = 2048, n3 = 512;
        for (int it = B; it < n1 + n2 + n3; it += G) {
            if (it < n1) gla_item(p, L, it, 3, smem);
            else if (it < n1 + n2) s5_item(p, L, it - n1, 3, smem);
            else lru_pass(p, L, it - n1 - n2, 1);
        }
    } break;
    case 4: {
        const int n1 = 128 * 4, n2 = 8;
        const bf16_t* Wg = (const bf16_t*)(ws + WT_GLU);
        bf16_t* yc = R3 + C_Q;
        const float* bias = p.in[25] + L * 512;
        for (int it = B; it < n1 + n2; it += G) {
            if (it < n1) {
                const int mt = it >> 2, nt = it & 3;
                const int m0 = mt * 128, n0 = nt * 128;
                f32x4 acc[4][4];
                zero_acc<4>(acc);
                gemm_mainloop<4>(acc, R3 + (size_t)m0 * PROJ_LD + C_US5, PROJ_LD, Wg + (size_t)n0 * 512, 512, 512, smem);
                epi_foreach<4>(acc, m0, n0, [&](int row, int col, f32x4 v) {
                    const f32x4 bv = *(const f32x4*)(bias + col);
                    const uint2 zz = *(const uint2*)(R3 + (size_t)row * PROJ_LD + C_US5 + col);
                    f32x4 y;
                    y[0] = lo_bf(zz.x) * sigmoid_(v[0] + bv[0]); y[1] = hi_bf(zz.x) * sigmoid_(v[1] + bv[1]);
                    y[2] = lo_bf(zz.y) * sigmoid_(v[2] + bv[2]); y[3] = hi_bf(zz.y) * sigmoid_(v[3] + bv[3]);
                    *(uint2*)(yc + (size_t)row * PROJ_LD + col) = pack4(y);
                });
            } else lru_scan(p, it - n1);
        }
    } break;
    case 5: {
        for (int it = B; it < 512; it += G) lru_pass(p, L, it, 3);
    } break;
    case 6: {
        const bf16_t* Wt = (const bf16_t*)(ws + WT_IN);
        const bf16_t* Wb = (const bf16_t*)(ws + WT_BR);
        const float* bias = p.in[5] + (size_t)L * 6160 + 3088;
        bf16_t* mg = (bf16_t*)(ws + OFF_R5);
        for (int it = B; it < 256 * 8; it += G) {
            const int mt = it >> 3, nt = it & 7;
            const int m0 = mt * 64, n0 = nt * 128;
            f32x4 m[2][4];
            zero_acc<2>(m);
#pragma unroll 1
            for (int n = 0; n < 3; ++n) {
                f32x4 ag[2][4], ab[2][4];
                zero_acc<2>(ag);
                gemm_mainloop<2>(ag, hb + (size_t)m0 * DM, DM, Wt + (size_t)(3200 + n * 1024 + n0) * DM, DM, DM, smem);
                const bf16_t* yA = (n == 0) ? (R3 + C_ULRU) : (n == 1 ? (R3 + C_OG) : (R3 + C_Q));
                const int ldy = PROJ_LD;
                zero_acc<2>(ab);
                gemm_mainloop<2>(ab, yA + (size_t)m0 * ldy, ldy, Wb + (size_t)(n * 1024 + n0) * 512, 512, 512, smem);
                const int lane = TIDX() & 63, wc = (TIDX() >> 6) & 1;
#pragma unroll
                for (int mi = 0; mi < 2; ++mi)
#pragma unroll
                    for (int ni = 0; ni < 4; ++ni) {
                        const int col = n0 + wc * 64 + ni * 16 + (lane >> 4) * 4;
                        const f32x4 bv = *(const f32x4*)(bias + n * 1024 + col);
#pragma unroll
                        for (int r = 0; r < 4; ++r) m[mi][ni][r] += sigmoid_(ag[mi][ni][r] + bv[r]) * ab[mi][ni][r];
                    }
            }
            epi_foreach<2>(m, m0, n0, [&](int row, int col, f32x4 v) { *(uint2*)(mg + (size_t)row * DM + col) = pack4(v); });
        }
    } break;
    case 7: {
        const bf16_t* mg = (const bf16_t*)(ws + OFF_R5);
        const bf16_t* Wm = (const bf16_t*)(ws + WT_MIX);
        for (int it = B; it < 128 * 8; it += G) gemm_tile_resid(mg, DM, Wm, DM, DM, p.out, (it >> 3) * 128, (it & 7) * 128, smem);
    } break;
    case 8: {
        const int n1 = NTOK / 4, n2 = p.wb[L][NWB - 1].tile_end;
        for (int it = B; it < n1 + n2; it += G) {
            if (it < n1) ln_rows(p.out, p.out, hb, p.in[28] + L * DM, p.in[29] + L * DM, it);
            else conv_w_set(p.wb[L], NWB, it - n1, smem);
        }
    } break;
    case 9: {
        const int n1 = 128 * 8, n2 = 8 * 8, n3 = 4 * 8 * 2;
        const bf16_t* Wq = (const bf16_t*)(ws + WT_Q);
        const bf16_t* Wkv = (const bf16_t*)(ws + WT_KV);
        const bf16_t* memb = (const bf16_t*)(ws + OFF_MEMB);
        for (int it = B; it < n1 + n2 + n3; it += G) {
            if (it < n1) gemm_tile_bf16(hb, DM, Wq, DM, DM, (bf16_t*)(ws + OFF_XQ), DM, (it >> 3) * 128, (it & 7) * 128, nullptr, 0.0625f, smem);
            else if (it < n1 + n2) { const int t = it - n1; gemm_tile_bf16(memb, DM, Wkv, DM, DM, (bf16_t*)(ws + OFF_KB), DM, (t >> 3) * 128, (t & 7) * 128, nullptr, 1.f, smem); }
            else {
                const int t = it - n1 - n2; const int b = t >> 4, mt = (t >> 1) & 7, nt = t & 1;
                gemm_tile_bf16(Wkv + (size_t)1024 * DM, DM, memb + (size_t)b * 256 * DM, DM, DM, (bf16_t*)(ws + OFF_VT) + (size_t)b * 1024 * 256, 256, mt * 128, nt * 128, nullptr, 1.f, smem);
            }
        }
    } break;
    case 10: {
        for (int it = B; it < 16 * 32 * 2; it += G) {
            const int nt = it & 1, mt = (it >> 1) & 31, z = it >> 6, b = z >> 2, h = z & 3;
            gemm_tile_bf16((const bf16_t*)(ws + OFF_XQ) + (size_t)b * SEQ * DM + h * 256, DM, (const bf16_t*)(ws + OFF_KB) + (size_t)b * 256 * DM + h * 256, DM, 256,
                           (bf16_t*)(ws + OFF_XS) + (size_t)z * SEQ * 256, 256, mt * 128, nt * 128, nullptr, 1.f, smem);
        }
    } break;
    case 11: {
        for (int it = B; it < 4096; it += G) softmax_item(p, it);
    } break;
    case 12: {
        for (int it = B; it < 16 * 32 * 2; it += G) {
            const int nt = it & 1, mt = (it >> 1) & 31, z = it >> 6, b = z >> 2, h = z & 3;
            gemm_tile_bf16((const bf16_t*)(ws + OFF_XS) + (size_t)z * SEQ * 256, 256, (const bf16_t*)(ws + OFF_VT) + (size_t)b * 1024 * 256 + (size_t)h * 256 * 256, 256, 256,
                           (bf16_t*)(ws + OFF_XO) + (size_t)b * SEQ * DM + h * 256, DM, mt * 128, nt * 128, nullptr, 1.f, smem);
        }
    } break;
    case 13: {
        for (int it = B; it < 128 * 8; it += G) gemm_tile_resid((const bf16_t*)(ws + OFF_XO), DM, (const bf16_t*)(ws + WT_O), DM, DM, p.out, (it >> 3) * 128, (it & 7) * 128, smem);
    } break;
    case 14: {
        const int n1 = NTOK / 4, n2 = (L + 1 < 2) ? p.wa[1][NWA - 1].tile_end : 0;
        for (int it = B; it < n1 + n2; it += G) {
            if (it < n1) ln_rows(p.out, p.out, hb, p.in[33] + L * DM, p.in[34] + L * DM, it);
            else conv_w_set(p.wa[1], NWA, it - n1, smem);
        }
    } break;
    case 15: {
        const bf16_t* Wgu = (const bf16_t*)(ws + WT_GU);
        bf16_t* act = (bf16_t*)(ws + OFF_ACT);
        for (int it = B; it < 128 * 44; it += G) {
            const int mt = it / 44, nt = it % 44;
            const int m0 = mt * 128;
            f32x4 acc[4][4];
            zero_acc<4>(acc);
            gemm_mainloop<4>(acc, hb + (size_t)m0 * DM, DM, Wgu + (size_t)nt * 128 * DM, DM, DM, smem);
            const int lane = TIDX() & 63, wave = TIDX() >> 6, wr = wave >> 1, wc = wave & 1;
#pragma unroll
            for (int mi = 0; mi < 4; ++mi)
#pragma unroll
                for (int ni = 0; ni < 2; ++ni) {
                    const int row = m0 + wr * 64 + mi * 16 + (lane & 15);
                    const int col = nt * 64 + wc * 32 + ni * 16 + (lane >> 4) * 4;
                    f32x4 y;
#pragma unroll
                    for (int r = 0; r < 4; ++r) { const float gte = acc[mi][ni][r]; y[r] = gte * sigmoid_(gte) * acc[mi][ni + 2][r]; }
                    *(uint2*)(act + (size_t)row * DFF + col) = pack4(y);
                }
        }
    } break;
    case 16: {
        for (int it = B; it < 128 * 8; it += G) gemm_tile_resid((const bf16_t*)(ws + OFF_ACT), DFF, (const bf16_t*)(ws + WT_DN), DFF, DFF, p.out, (it >> 3) * 128, (it & 7) * 128, smem);
    } break;
    case 17: {
        for (int it = B; it < NTOK / 4; it += G) ln_rows(p.out, p.out, hb, p.in[37] + L * DM, p.in[38] + L * DM, it);
    } break;
    }
}

#define XB_TMO      128
#define XB_XCNT(j)  (256  + 64 * (j))
#define XB_XSUB(j)  (1280 + 64 * (j))
#define XB_XGEN(j)  (2304 + 64 * (j))
#define XB_TOP      3328
#define XB_TOPGEN   3392
#define XCD_BAR_WORDS 3456
#define XB_SPIN_CAP (1u << 21)
#define LAS __attribute__((address_space(3)))
__device__ __forceinline__ unsigned xb_ld(unsigned* p)              { return __hip_atomic_load(p, __ATOMIC_RELAXED, __HIP_MEMORY_SCOPE_AGENT); }
__device__ __forceinline__ unsigned xb_add(unsigned* p, unsigned v) { return __hip_atomic_fetch_add(p, v, __ATOMIC_RELAXED, __HIP_MEMORY_SCOPE_AGENT); }
__device__ __forceinline__ unsigned xb_xcc_id() { return (unsigned)__builtin_amdgcn_s_getreg((3 << 11) | 20) & 0xFu; }
#define XB_SPIN(cond, bar) do { unsigned _sp = 0; while (cond) { __builtin_amdgcn_s_sleep(1); \
    if ((++_sp & 255u) == 0u) { if (xb_ld(&(bar)[XB_TMO])) break; if (_sp > XB_SPIN_CAP) { atomicAdd(&(bar)[XB_TMO], 1u); break; } } } } while (0)
struct XcdBarrier { unsigned* bar; unsigned x; volatile LAS unsigned* st; };
__device__ __forceinline__ XcdBarrier xcd_barrier_post(unsigned* bar, volatile LAS unsigned* st) {
    XcdBarrier b; b.bar = bar; b.x = xb_xcc_id(); b.st = st;
    if (threadIdx.x == 0) (void)xb_add(&bar[XB_XCNT(b.x)], 1u);
    return b;
}
__device__ __forceinline__ void xcd_barrier_complete(unsigned* bar, unsigned x, unsigned& nloc, unsigned& nx) {
    const unsigned G = gridDim.x * gridDim.y * gridDim.z;
    unsigned sum, cnt, mine, sp = 0u;
    for (;;) {
        sum = 0u; cnt = 0u; mine = 0u;
#pragma unroll
        for (unsigned j = 0; j < 16; ++j) { const unsigned c = xb_ld(&bar[XB_XCNT(j)]); sum += c; cnt += (c > 0u) ? 1u : 0u; mine = (j == x) ? c : mine; }
        if (sum == G) break;
        __builtin_amdgcn_s_sleep(1);
        if ((++sp & 255u) == 0u) { if (xb_ld(&bar[XB_TMO])) break; if (sp > XB_SPIN_CAP) { atomicAdd(&bar[XB_TMO], 1u); break; } }
    }
    nloc = mine > 0u ? mine : 1u; nx = cnt > 0u ? cnt : 1u;
}
__device__ __forceinline__ void xcd_barrier(const XcdBarrier& b) {
    asm volatile("s_waitcnt vmcnt(0)" ::: "memory");
    __syncthreads();
    if (threadIdx.x == 0) {
        unsigned* bar = b.bar;
        __builtin_amdgcn_s_waitcnt(0);
        unsigned nloc = b.st[0], nx = b.st[1];
        if (nloc == 0u) { xcd_barrier_complete(bar, b.x, nloc, nx); b.st[0] = nloc; b.st[1] = nx; }
        const unsigned old = xb_add(&bar[XB_XSUB(b.x)], 1u);
        const unsigned gen = old / nloc;
        if (old + 1u == (gen + 1u) * nloc) {
            __builtin_amdgcn_fence(__ATOMIC_RELEASE, "agent");
            asm volatile("s_waitcnt vmcnt(0)" ::: "memory");
            const unsigned og = xb_add(&bar[XB_TOP], 1u);
            const unsigned tg = og / nx;
            if (og + 1u == (tg + 1u) * nx) xb_add(&bar[XB_TOPGEN], 1u);
            else XB_SPIN(xb_ld(&bar[XB_TOPGEN]) == tg, bar);
            __builtin_amdgcn_fence(__ATOMIC_ACQUIRE, "agent");
            xb_add(&bar[XB_XGEN(b.x)], 1u);
            asm volatile("s_waitcnt vmcnt(0)" ::: "memory");
        } else {
            XB_SPIN(xb_ld(&bar[XB_XGEN(b.x)]) == gen, bar);
            __builtin_amdgcn_fence(__ATOMIC_ACQUIRE, "agent");
            asm volatile("s_waitcnt vmcnt(0)" ::: "memory");
        }
    }
    __syncthreads();
}

__global__ void __launch_bounds__(256, 2) fwd_megakernel(Params p) {
    extern __shared__ __attribute__((aligned(16))) char smem[];
    __shared__ uint4 xb_words;
    cg::grid_group grid = cg::this_grid();
    if (threadIdx.x == 0) xb_words = make_uint4(0u, 0u, 0u, 0u);
    __syncthreads();
    XcdBarrier xb = xcd_barrier_post((unsigned*)(p.ws + OFF_BAR), (volatile LAS unsigned*)&xb_words);
    if (p.ph_lo < 0) grid.sync();
    for (int ph = p.ph_lo; ph < p.ph_hi; ++ph) {
        run_phase(p, ph, smem);
        if (ph + 1 < p.ph_hi) xcd_barrier(xb);
    }
}

static void add_job(CJob* jobs, int& n, int& tiles, const float* src, bf16_t* dst, int ld, int K, int nrows, int mode) {
    tiles += (nrows / 64) * (K / 64);
    jobs[n].src = src; jobs[n].dst = dst; jobs[n].ld = ld; jobs[n].K = K; jobs[n].mode = mode; jobs[n].tile_end = tiles;
    ++n;
}

extern "C" void kernel_launch(void* const* d_in, const int* in_sizes, int n_in, void* d_out, int out_size, void* d_ws, size_t ws_size, hipStream_t stream) {
    static int grid_blocks = 0;
    if (grid_blocks == 0) {
        if (n_in != 39 || ws_size < WS_END) { fprintf(stderr, "kernel_launch: unexpected n_in %d or ws_size %zu (< %zu)\n", n_in, ws_size, (size_t)WS_END); grid_blocks = -1; return; }
        int dev = 0, cus = 0, per_cu = 0;
        hipGetDevice(&dev);
        hipDeviceGetAttribute(&cus, hipDeviceAttributeMultiprocessorCount, dev);
        if (hipFuncSetAttribute((const void*)fwd_megakernel, hipFuncAttributeMaxDynamicSharedMemorySize, SMEM_BYTES) != hipSuccess) { fprintf(stderr, "hipFuncSetAttribute failed\n"); grid_blocks = -1; return; }
        if (hipOccupancyMaxActiveBlocksPerMultiprocessor(&per_cu, (const void*)fwd_megakernel, 256, SMEM_BYTES) != hipSuccess || per_cu < 1) { fprintf(stderr, "occupancy query failed\n"); grid_blocks = -1; return; }
        if (per_cu > 2) per_cu = 2;
        grid_blocks = cus * per_cu;
    }
    if (grid_blocks < 0) return;
    Params p{};
    for (int i = 0; i < 39; ++i) p.in[i] = (const float*)d_in[i];
    p.out = (float*)d_out;
    p.ws = (char*)d_ws;
    char* ws = (char*)d_ws;
    for (int L = 0; L < 2; ++L) {
        int n = 0, t = 0;
        add_job(p.wa[L], n, t, p.in[4] + (size_t)L * 1024 * 6160, (bf16_t*)(ws + WT_IN), 6160, 1024, 6272, 1);
        for (int h = 0; h < 4; ++h) {
            add_job(p.wa[L], n, t, p.in[8] + (size_t)(L * 4 + h) * 128 * 128, (bf16_t*)(ws + WT_LRU) + (size_t)h * 256 * 128, 128, 128, 128, 0);
            add_job(p.wa[L], n, t, p.in[10] + (size_t)(L * 4 + h) * 128 * 128, (bf16_t*)(ws + WT_LRU) + (size_t)h * 256 * 128 + 128 * 128, 128, 128, 128, 0);
        }
        add_job(p.wa[L], n, t, p.in[24] + (size_t)L * 512 * 512, (bf16_t*)(ws + WT_GLU), 512, 512, 512, 0);
        for (int b = 0; b < 3; ++b) add_job(p.wa[L], n, t, p.in[26] + (size_t)(L * 3 + b) * 512 * 1024, (bf16_t*)(ws + WT_BR) + (size_t)b * 1024 * 512, 1024, 512, 1024, 0);
        add_job(p.wa[L], n, t, p.in[27] + (size_t)L * 1024 * 1024, (bf16_t*)(ws + WT_MIX), 1024, 1024, 1024, 0);
        n = 0; t = 0;
        add_job(p.wb[L], n, t, p.in[30] + (size_t)L * 1024 * 1024, (bf16_t*)(ws + WT_Q), 1024, 1024, 1024, 0);
        add_job(p.wb[L], n, t, p.in[31] + (size_t)L * 1024 * 2048, (bf16_t*)(ws + WT_KV), 2048, 1024, 2048, 0);
        add_job(p.wb[L], n, t, p.in[32] + (size_t)L * 1024 * 1024, (bf16_t*)(ws + WT_O), 1024, 1024, 1024, 0);
        add_job(p.wb[L], n, t, p.in[35] + (size_t)L * 1024 * 5632, (bf16_t*)(ws + WT_GU), 5632, 1024, 5632, 2);
        add_job(p.wb[L], n, t, p.in[36] + (size_t)L * 2816 * 1024, (bf16_t*)(ws + WT_DN), 1024, 2816, 1024, 0);
    }
    if (hipMemsetAsync(ws + OFF_BAR, 0, 3456 * 4, stream) != hipSuccess) { fprintf(stderr, "memset failed\n"); return; }
#if SINGLE_LAUNCH
    p.ph_lo = 0; p.ph_hi = N_PHASES;
    void* args[] = {&p};
    hipError_t e = hipLaunchCooperativeKernel((const void*)fwd_megakernel, dim3(grid_blocks), dim3(256), args, SMEM_BYTES, stream);
    if (e != hipSuccess) fprintf(stderr, "cooperative launch failed: %s (grid %d)\n", hipGetErrorString(e), grid_blocks);
#else
    for (int ph = 0; ph < N_PHASES; ++ph) {
        p.ph_lo = ph; p.ph_hi = ph + 1;
        hipLaunchKernelGGL(fwd_megakernel, dim3(grid_blocks), dim3(256), SMEM_BYTES, stream, p);
    }
#endif
}
```

```cpp
#include <hip/hip_runtime.h>
#include <hip/hip_cooperative_groups.h>
#include <cstdio>
namespace cg = cooperative_groups;

#ifndef SINGLE_LAUNCH
#define SINGLE_LAUNCH 1
#endif

typedef unsigned short bf16_t;
typedef short bf16x8 __attribute__((ext_vector_type(8)));
typedef float f32x4 __attribute__((ext_vector_type(4)));

constexpr int NTOK = 16384, DM = 1024, SEQ = 4096, NB = 4;
constexpr int PROJ_LD = 3072;
constexpr int C_ULRU = 0, C_GLRU = 512, C_Q = 1024, C_K = 1280, C_V = 1536, C_OG = 2048, C_US5 = 2560;
constexpr int DFF = 2816;
constexpr float DN_ALPHA = 1.4142135623730951f;
constexpr float LN_EPS = 1e-5f;

constexpr size_t WT_IN = 0;
constexpr size_t WT_LRU = WT_IN + 6208ull * 1024 * 2;
constexpr size_t WT_GLU = WT_LRU + 4ull * 256 * 128 * 2;
constexpr size_t WT_BR = WT_GLU + 512ull * 512 * 2;
constexpr size_t WT_MIX = WT_BR + 3ull * 1024 * 512 * 2;
constexpr size_t OFF_HB = WT_MIX + 1024ull * 1024 * 2;
constexpr size_t OFF_MEMB = OFF_HB + 16384ull * 1024 * 2;
constexpr size_t OFF_R3 = OFF_MEMB + 1024ull * 1024 * 2;
constexpr size_t OFF_R4 = OFF_R3 + 16384ull * 3072 * 2;
constexpr size_t OFF_UC = OFF_R4;
constexpr size_t OFF_GL = OFF_R4 + 16384ull * 512 * 2;
constexpr size_t OFF_R5 = OFF_GL + 16384ull * 1024 * 2;
constexpr size_t OFF_S5C = OFF_R5 + 1024ull * 8192 * 4;
constexpr size_t OFF_LRUP = OFF_S5C + 4ull * 64 * 32 * 64 * 8;
constexpr size_t OFF_LRUH = OFF_LRUP + 4ull * 64 * 512 * 4;
constexpr size_t OFF_DEC = OFF_LRUH + 4ull * 64 * 512 * 4;
constexpr size_t OFF_KB = OFF_DEC + 1024ull * 64 * 4;
constexpr size_t OFF_VT = OFF_KB + 1024ull * 1024 * 2;
constexpr size_t OFF_LRB = OFF_VT + 1024ull * 1024 * 2;
constexpr size_t OFF_BAR = OFF_LRB + 16384ull * 16 * 2;
constexpr size_t WS_END = OFF_BAR + 3456 * 4;
constexpr size_t WT_Q = OFF_GL;
constexpr size_t WT_KV = WT_Q + 1024ull * 1024 * 2;
constexpr size_t WT_O = WT_KV + 2048ull * 1024 * 2;
constexpr size_t WT_GU = WT_O + 1024ull * 1024 * 2;
constexpr size_t WT_DN = WT_GU + 5632ull * 1024 * 2;
static_assert(WT_DN + 1024ull * 2816 * 2 <= OFF_R5, "wb overflow");
constexpr size_t OFF_XQ = OFF_R3;
constexpr size_t OFF_XS = OFF_R3 + 16384ull * 1024 * 2;
constexpr size_t OFF_XO = OFF_XS + 16384ull * 1024 * 2;
constexpr size_t OFF_ACT = OFF_R3;

constexpr int HALF_SMEM = 73728;
constexpr int XB_LDS_OFF = 2 * HALF_SMEM;
constexpr int SMEM_BYTES = 2 * HALF_SMEM + 256;

struct CJob { const float* src; bf16_t* dst; int ld, K, mode, tile_end; };
constexpr int NWA = 14, NWB = 5;
struct Params {
    const float* in[39];
    float* out;
    char* ws;
    CJob wa[2][NWA];
    CJob wb[2][NWB];
    int ph_lo, ph_hi;
};

__device__ __forceinline__ int TIDX() { int t = threadIdx.x; asm volatile("" : "+v"(t)); return t; }
__device__ __forceinline__ int TID() { return TIDX() & 255; }
__device__ __forceinline__ float bf2f(bf16_t b) { return __uint_as_float(((unsigned)b) << 16); }
__device__ __forceinline__ unsigned cvt_pk_bf16(float lo, float hi) { unsigned r; asm volatile("v_cvt_pk_bf16_f32 %0, %1, %2" : "=v"(r) : "v"(lo), "v"(hi)); return r; }
__device__ __forceinline__ bf16_t f2bf(float f) { return (bf16_t)(cvt_pk_bf16(f, 0.f) & 0xffffu); }
__device__ __forceinline__ float lo_bf(unsigned u) { return __uint_as_float(u << 16); }
__device__ __forceinline__ float hi_bf(unsigned u) { return __uint_as_float(u & 0xffff0000u); }
__device__ __forceinline__ float sigmoid_(float x) { return 1.f / (1.f + __expf(-x)); }
__device__ __forceinline__ float gelu_t(float x) { float u = 1.5957691216057308f * (x + 0.044715f * x * x * x); return x / (1.f + __expf(-u)); }
__device__ __forceinline__ float logsigmoid_(float x) { return fminf(x, 0.f) - log1pf(__expf(-fabsf(x))); }
__device__ __forceinline__ uint2 pack4(f32x4 v) { uint2 r; r.x = cvt_pk_bf16(v[0], v[1]); r.y = cvt_pk_bf16(v[2], v[3]); return r; }
__device__ __forceinline__ float wave_sum(float v) {
#pragma unroll
    for (int o = 32; o > 0; o >>= 1) v += __shfl_xor(v, o);
    return v;
}
__device__ __forceinline__ float wave_max(float v) {
#pragma unroll
    for (int o = 32; o > 0; o >>= 1) v = fmaxf(v, __shfl_xor(v, o));
    return v;
}

template <int MT>
__device__ __forceinline__ void gemm_mainloop(f32x4 (&acc)[MT][4], const bf16_t* __restrict__ A, int lda, const bf16_t* __restrict__ Bt, int ldb, int K, char* smem) {
    constexpr int BM = MT * 32;
    constexpr int A_BYTES = BM * 144, STAGE = A_BYTES + 128 * 144;
    constexpr int NA = MT;
    const int tid = TID(), lane = tid & 63, wave = tid >> 6, wr = wave >> 1, wc = wave & 1;
    const int prow = tid >> 3, pc = tid & 7;
    const bf16_t* ag = A + (size_t)prow * lda + pc * 8;
    const bf16_t* bg = Bt + (size_t)prow * ldb + pc * 8;
    const int soff = prow * 144 + pc * 16;
    const int fa = (wr * MT * 16 + (lane & 15)) * 144 + (lane >> 4) * 16;
    const int fb = A_BYTES + (wc * 64 + (lane & 15)) * 144 + (lane >> 4) * 16;
    uint4 ra[NA], rb[4];
    const int nk = K >> 6;
#pragma unroll
    for (int i = 0; i < NA; ++i) ra[i] = *(const uint4*)(ag + (size_t)(i * 32) * lda);
#pragma unroll
    for (int i = 0; i < 4; ++i) rb[i] = *(const uint4*)(bg + (size_t)(i * 32) * ldb);
#pragma unroll
    for (int i = 0; i < NA; ++i) *(uint4*)(smem + soff + i * 32 * 144) = ra[i];
#pragma unroll
    for (int i = 0; i < 4; ++i) *(uint4*)(smem + A_BYTES + soff + i * 32 * 144) = rb[i];
    __syncthreads();
    for (int kt = 0; kt < nk; ++kt) {
        const bool more = (kt + 1 < nk);
        if (more) {
#pragma unroll
            for (int i = 0; i < NA; ++i) ra[i] = *(const uint4*)(ag + (size_t)(i * 32) * lda + (kt + 1) * 64);
#pragma unroll
            for (int i = 0; i < 4; ++i) rb[i] = *(const uint4*)(bg + (size_t)(i * 32) * ldb + (kt + 1) * 64);
        }
        const char* st = smem + (kt & 1) * STAGE;
#pragma unroll
        for (int ks = 0; ks < 2; ++ks) {
            bf16x8 af[MT], bfr[4];
#pragma unroll
            for (int mi = 0; mi < MT; ++mi) af[mi] = *(const bf16x8*)(st + fa + mi * 16 * 144 + ks * 64);
#pragma unroll
            for (int ni = 0; ni < 4; ++ni) bfr[ni] = *(const bf16x8*)(st + fb + ni * 16 * 144 + ks * 64);
#pragma unroll
            for (int mi = 0; mi < MT; ++mi)
#pragma unroll
                for (int ni = 0; ni < 4; ++ni) acc[mi][ni] = __builtin_amdgcn_mfma_f32_16x16x32_bf16(bfr[ni], af[mi], acc[mi][ni], 0, 0, 0);
        }
        if (more) {
            char* sw = smem + ((kt + 1) & 1) * STAGE;
#pragma unroll
            for (int i = 0; i < NA; ++i) *(uint4*)(sw + soff + i * 32 * 144) = ra[i];
#pragma unroll
            for (int i = 0; i < 4; ++i) *(uint4*)(sw + A_BYTES + soff + i * 32 * 144) = rb[i];
        }
        __syncthreads();
    }
}

template <int MT>
__device__ __forceinline__ void zero_acc(f32x4 (&acc)[MT][4]) {
#pragma unroll
    for (int mi = 0; mi < MT; ++mi)
#pragma unroll
        for (int ni = 0; ni < 4; ++ni) acc[mi][ni] = (f32x4){0.f, 0.f, 0.f, 0.f};
}
template <int MT, class F>
__device__ __forceinline__ void epi_foreach(f32x4 (&acc)[MT][4], int m0, int n0, F f) {
    const int lane = TID() & 63, wave = TID() >> 6, wr = wave >> 1, wc = wave & 1;
#pragma unroll
    for (int mi = 0; mi < MT; ++mi)
#pragma unroll
        for (int ni = 0; ni < 4; ++ni) f(m0 + wr * MT * 16 + mi * 16 + (lane & 15), n0 + wc * 64 + ni * 16 + (lane >> 4) * 4, acc[mi][ni]);
}

__device__ __forceinline__ void gemm_tile_bf16(const bf16_t* A, int lda, const bf16_t* Bt, int ldb, int K, bf16_t* C, int ldc, int m0, int n0, const float* bias, float scale, char* smem) {
    f32x4 acc[4][4];
    zero_acc<4>(acc);
    gemm_mainloop<4>(acc, A + (size_t)m0 * lda, lda, Bt + (size_t)n0 * ldb, ldb, K, smem);
    epi_foreach<4>(acc, m0, n0, [&](int row, int col, f32x4 v) {
        f32x4 bv = {0.f, 0.f, 0.f, 0.f};
        if (bias) bv = *(const f32x4*)(bias + col);
        v = v * scale + bv;
        *(uint2*)(C + (size_t)row * ldc + col) = pack4(v);
    });
}
__device__ __forceinline__ void gemm_tile_resid(const bf16_t* A, int lda, const bf16_t* Bt, int ldb, int K, float* out, int m0, int n0, char* smem) {
    f32x4 acc[4][4];
    zero_acc<4>(acc);
    gemm_mainloop<4>(acc, A + (size_t)m0 * lda, lda, Bt + (size_t)n0 * ldb, ldb, K, smem);
    epi_foreach<4>(acc, m0, n0, [&](int row, int col, f32x4 v) {
        f32x4* o = (f32x4*)(out + (size_t)row * DM + col);
        f32x4 h = *o;
        *o = h * DN_ALPHA + v;
    });
}

__device__ void conv_w_tile(const CJob& j, int tile, char* smem) {
    float* ts = (float*)smem;
    const int ktiles = j.K >> 6;
    const int nt = tile / ktiles, kt = tile - nt * ktiles;
    const int n0 = nt * 64, k0 = kt * 64;
    const int tid = TID();
    const int nn = tid & 63;
    const int n = n0 + nn;
    int col;
    if (j.mode == 0) col = n;
    else if (j.mode == 1) col = n < 2560 ? n : (n < 6144 ? n + 16 : (n < 6160 ? n - 3584 : -1));
    else {
        const int t = n >> 8, r = n & 255;
        col = (r < 128) ? (t * 128 + r) : (DFF + t * 128 + r - 128);
    }
#pragma unroll
    for (int i = 0; i < 16; ++i) {
        const int kk = (tid >> 6) + i * 4;
        ts[kk * 65 + nn] = col >= 0 ? j.src[(size_t)(k0 + kk) * j.ld + col] : 0.f;
    }
    __syncthreads();
    const int wn = tid >> 2, kg = tid & 3;
    unsigned pk[8];
#pragma unroll
    for (int e = 0; e < 8; ++e) pk[e] = cvt_pk_bf16(ts[(kg * 16 + 2 * e) * 65 + wn], ts[(kg * 16 + 2 * e + 1) * 65 + wn]);
    uint4* d = (uint4*)(j.dst + (size_t)(n0 + wn) * j.K + k0 + kg * 16);
    d[0] = make_uint4(pk[0], pk[1], pk[2], pk[3]);
    d[1] = make_uint4(pk[4], pk[5], pk[6], pk[7]);
    __syncthreads();
}
__device__ void conv_w_set(const CJob* jobs, int njobs, int tile, char* smem) {
    int prev = 0;
    for (int i = 0; i < njobs; ++i) {
        const int e = jobs[i].tile_end;
        if (tile < e) { conv_w_tile(jobs[i], tile - prev, smem); return; }
        prev = e;
    }
}

__device__ void ln_rows(const float* src, float* dst, bf16_t* hb, const float* g, const float* bta, int item) {
    const int lane = TID() & 63, wave = TID() >> 6;
    const int row = item * 4 + wave;
    const float4* s4 = (const float4*)(src + (size_t)row * DM);
    float4 v[4];
    float s = 0.f;
#pragma unroll
    for (int i = 0; i < 4; ++i) { v[i] = s4[lane + i * 64]; s += v[i].x + v[i].y + v[i].z + v[i].w; }
    const float mu = wave_sum(s) * (1.f / DM);
    float q = 0.f;
#pragma unroll
    for (int i = 0; i < 4; ++i) { float a = v[i].x - mu, b = v[i].y - mu, c = v[i].z - mu, d = v[i].w - mu; q += a * a + b * b + c * c + d * d; }
    const float rs = rsqrtf(wave_sum(q) * (1.f / DM) + LN_EPS);
#pragma unroll
    for (int i = 0; i < 4; ++i) {
        const int c4 = lane + i * 64;
        const float4 gg = ((const float4*)g)[c4], bb = ((const float4*)bta)[c4];
        float4 y;
        y.x = (v[i].x - mu) * rs * gg.x + bb.x; y.y = (v[i].y - mu) * rs * gg.y + bb.y;
        y.z = (v[i].z - mu) * rs * gg.z + bb.z; y.w = (v[i].w - mu) * rs * gg.w + bb.w;
        ((float4*)(dst + (size_t)row * DM))[c4] = y;
        uint2 pkd; pkd.x = cvt_pk_bf16(y.x, y.y); pkd.y = cvt_pk_bf16(y.z, y.w);
        ((uint2*)(hb + (size_t)row * DM))[c4] = pkd;
    }
}

__device__ void dwconv_item(const Params& p, int L, int item) {
    const int id = item * 256 + TID();
    const int tok = id >> 6, c0 = (id & 63) * 8;
    const int pos = tok & (SEQ - 1);
    const bf16_t* R3 = (const bf16_t*)(p.ws + OFF_R3);
    const float* w = p.in[6] + L * 4 * 512;
    const float* cb = p.in[7] + L * 512;
    float accv[8];
#pragma unroll
    for (int e = 0; e < 8; ++e) accv[e] = cb[c0 + e];
#pragma unroll
    for (int k = 0; k < 4; ++k) {
        const int d = 3 - k;
        if (pos >= d) {
            const uint4 u = *(const uint4*)(R3 + (size_t)(tok - d) * PROJ_LD + C_ULRU + c0);
            const float* wk = w + k * 512 + c0;
            accv[0] += wk[0] * lo_bf(u.x); accv[1] += wk[1] * hi_bf(u.x);
            accv[2] += wk[2] * lo_bf(u.y); accv[3] += wk[3] * hi_bf(u.y);
            accv[4] += wk[4] * lo_bf(u.z); accv[5] += wk[5] * hi_bf(u.z);
            accv[6] += wk[6] * lo_bf(u.w); accv[7] += wk[7] * hi_bf(u.w);
        }
    }
    uint4 o;
    o.x = cvt_pk_bf16(accv[0], accv[1]); o.y = cvt_pk_bf16(accv[2], accv[3]);
    o.z = cvt_pk_bf16(accv[4], accv[5]); o.w = cvt_pk_bf16(accv[6], accv[7]);
    *(uint4*)((bf16_t*)(p.ws + OFF_UC) + (size_t)tok * 512 + c0) = o;
}

__device__ void lru_pass(const Params& p, int L, int item, int pass) {
    const int id = item * 256 + TID();
    const int c = id & 511, bn = id >> 9;
    const size_t t0 = (size_t)bn * 64;
    const bf16_t* uc = (const bf16_t*)(p.ws + OFF_UC) + t0 * 512 + c;
    const bf16_t* gl = (const bf16_t*)(p.ws + OFF_GL) + t0 * 1024 + (c >> 7) * 256 + (c & 127);
    bf16_t* R3 = (bf16_t*)(p.ws + OFF_R3) + t0 * PROJ_LD;
    float* cP = (float*)(p.ws + OFF_LRUP);
    float* cH = (float*)(p.ws + OFF_LRUH);
    const float lam = p.in[12][L * 512 + c];
    const float sp8 = -8.f * log1pf(expf(-lam));
    float P = 1.f, H = 0.f;
    if (pass == 3) {
        const int nn = bn & 63, b0 = (bn >> 6) * 64;
        for (int k = 0; k < nn; ++k) { const int ix = (b0 + k) * 512 + c; H = cP[ix] * H + cH[ix]; }
    }
#pragma unroll 4
    for (int s = 0; s < 64; ++s) {
        const float rl = bf2f(gl[(size_t)s * 1024]);
        const float il = bf2f(gl[(size_t)s * 1024 + 128]);
        const float u = bf2f(uc[(size_t)s * 512]);
        const float la = sp8 * sigmoid_(rl);
        const float a = __expf(la);
        const float mult = sqrtf(-expm1f(2.f * la));
        const float bt = mult * sigmoid_(il) * u;
        H = a * H + bt;
        if (pass == 1) P *= a;
        else {
            const float gv = bf2f(R3[(size_t)s * PROJ_LD + C_GLRU + c]);
            R3[(size_t)s * PROJ_LD + C_ULRU + c] = f2bf(H * gelu_t(gv));
        }
    }
    if (pass == 1) { cP[id] = P; cH[id] = H; }
}
__device__ void s5_item(const Params& p, int L, int item, int pass, char* smem) {
    const int tid = TID(), lane = tid & 63, wave = tid >> 6;
    const int g = (item & 7) * 4 + wave, bn = item >> 3;
    const size_t t0 = (size_t)bn * 64;
    char* wsm = smem + wave * (4096 + 16 * 272);
    float* us = (float*)wsm;
    bf16_t* xs = (bf16_t*)(wsm + 4096);
    bf16_t* R3 = (bf16_t*)(p.ws + OFF_R3) + t0 * PROJ_LD + C_US5 + g * 16;
    const int sp = (L * 32 + g) * 64 + lane;
    const float dt = expf(p.in[18][L * 32 + g]);
    const float lre = p.in[16][sp], lim = p.in[17][sp];
    const float th = lim * dt;
    const float sn = sinf(th), cs = cosf(th);
    const float em1 = expm1f(lre * dt);
    const float ar = (em1 + 1.f) * cs, ai = (em1 + 1.f) * sn;
    const float shh = sinf(0.5f * th);
    const float arm1 = em1 * cs - 2.f * shh * shh;
    const float den = lre * lre + lim * lim;
    const float fre = (arm1 * lre + ai * lim) / den, fim = (ai * lre - arm1 * lim) / den;
    float bbr[16], bbi[16];
    {
        const float4* br4 = (const float4*)(p.in[19] + (size_t)sp * 16);
        const float4* bi4 = (const float4*)(p.in[20] + (size_t)sp * 16);
#pragma unroll
        for (int i = 0; i < 4; ++i) {
            const float4 r = br4[i], m = bi4[i];
            bbr[4 * i + 0] = fre * r.x - fim * m.x; bbi[4 * i + 0] = fre * m.x + fim * r.x;
            bbr[4 * i + 1] = fre * r.y - fim * m.y; bbi[4 * i + 1] = fre * m.y + fim * r.y;
            bbr[4 * i + 2] = fre * r.z - fim * m.z; bbi[4 * i + 2] = fre * m.z + fim * r.z;
            bbr[4 * i + 3] = fre * r.w - fim * m.w; bbi[4 * i + 3] = fre * m.w + fim * r.w;
        }
    }
    {
        const uint4 a = *(const uint4*)(R3 + (size_t)lane * PROJ_LD);
        const uint4 b = *(const uint4*)(R3 + (size_t)lane * PROJ_LD + 8);
        float4* d = (float4*)(us + lane * 16);
        d[0] = make_float4(lo_bf(a.x), hi_bf(a.x), lo_bf(a.y), hi_bf(a.y));
        d[1] = make_float4(lo_bf(a.z), hi_bf(a.z), lo_bf(a.w), hi_bf(a.w));
        d[2] = make_float4(lo_bf(b.x), hi_bf(b.x), lo_bf(b.y), hi_bf(b.y));
        d[3] = make_float4(lo_bf(b.z), hi_bf(b.z), lo_bf(b.w), hi_bf(b.w));
    }
    float2* carry = (float2*)(p.ws + OFF_S5C) + ((size_t)bn * 32 + g) * 64 + lane;
    float xr = 0.f, xi = 0.f;
    bf16x8 cf[4];
    if (pass == 3) {
        {
            float a6r = ar, a6i = ai;
#pragma unroll
            for (int i = 0; i < 6; ++i) { const float r = a6r * a6r - a6i * a6i, m = 2.f * a6r * a6i; a6r = r; a6i = m; }
            const int nn = bn & 63;
            const float2* cb = (const float2*)(p.ws + OFF_S5C) + ((size_t)(bn - nn) * 32 + g) * 64 + lane;
            for (int k = 0; k < nn; ++k) {
                const float2 l = cb[(size_t)k * 2048];
                const float nr = a6r * xr - a6i * xi + l.x, ni = a6r * xi + a6i * xr + l.y;
                xr = nr; xi = ni;
            }
        }
        const int ci = lane & 15, kq = (lane >> 4) * 8;
        const float* cre = p.in[21] + ((size_t)(L * 32 + g) * 16 + ci) * 64;
        const float* cim = p.in[22] + ((size_t)(L * 32 + g) * 16 + ci) * 64;
#pragma unroll
        for (int ks = 0; ks < 4; ++ks) {
            const float* s = (ks < 2 ? cre : cim) + (ks & 1) * 32 + kq;
            const float sg = ks < 2 ? 1.f : -1.f;
            const float4 a = *(const float4*)s, b = *(const float4*)(s + 4);
            union { bf16x8 v; unsigned u[4]; } t;
            t.u[0] = cvt_pk_bf16(sg * a.x, sg * a.y); t.u[1] = cvt_pk_bf16(sg * a.z, sg * a.w);
            t.u[2] = cvt_pk_bf16(sg * b.x, sg * b.y); t.u[3] = cvt_pk_bf16(sg * b.z, sg * b.w);
            cf[ks] = t.v;
        }
    }
    __syncthreads();
    for (int j = 0; j < 4; ++j) {
#pragma unroll 4
        for (int s = 0; s < 16; ++s) {
            const float4* u4 = (const float4*)(us + (j * 16 + s) * 16);
            float bre = 0.f, bim = 0.f;
#pragma unroll
            for (int i = 0; i < 4; ++i) {
                const float4 u = u4[i];
                bre += bbr[4 * i] * u.x + bbr[4 * i + 1] * u.y + bbr[4 * i + 2] * u.z + bbr[4 * i + 3] * u.w;
                bim += bbi[4 * i] * u.x + bbi[4 * i + 1] * u.y + bbi[4 * i + 2] * u.z + bbi[4 * i + 3] * u.w;
            }
            const float nr = ar * xr - ai * xi + bre;
            const float ni = ar * xi + ai * xr + bim;
            xr = nr; xi = ni;
            if (pass == 3) { xs[s * 136 + lane] = f2bf(xr); xs[s * 136 + 64 + lane] = f2bf(xi); }
        }
        if (pass == 3) {
            f32x4 acc = {0.f, 0.f, 0.f, 0.f};
#pragma unroll
            for (int ks = 0; ks < 4; ++ks) {
                const bf16x8 af = *(const bf16x8*)(xs + (lane & 15) * 136 + ks * 32 + (lane >> 4) * 8);
                acc = __builtin_amdgcn_mfma_f32_16x16x32_bf16(cf[ks], af, acc, 0, 0, 0);
            }
            const int sa = j * 16 + (lane & 15), i0 = (lane >> 4) * 4;
            const float4 uu = *(const float4*)(us + sa * 16 + i0);
            const float4 dd = *(const float4*)(p.in[23] + L * 512 + g * 16 + i0);
            f32x4 z;
            z[0] = gelu_t(acc[0] + dd.x * uu.x); z[1] = gelu_t(acc[1] + dd.y * uu.y);
            z[2] = gelu_t(acc[2] + dd.z * uu.z); z[3] = gelu_t(acc[3] + dd.w * uu.w);
            *(uint2*)(R3 + (size_t)sa * PROJ_LD + i0) = pack4(z);
        }
    }
    if (pass == 1) *carry = make_float2(xr, xi);
    __syncthreads();
}
__device__ void gla_item(const Params& p, int L, int item, int pass, char* smem) {
    const int tid = TID(), lane = tid & 63, wave = tid >> 6;
    const int n = item & 63, bh = item >> 6, h = bh & 3, b = bh >> 2;
    const size_t t0 = (size_t)b * SEQ + n * 64;
    bf16_t* pr = (bf16_t*)(p.ws + OFF_R3) + t0 * PROJ_LD;
    float* lrs = (float*)smem;
    float* tot = (float*)(smem + 4096);
    bf16_t* qd = (bf16_t*)(smem + 5120);
    bf16_t* ki = (bf16_t*)(smem + 5120 + 9216);
    bf16_t* vT = (bf16_t*)(smem + 5120 + 18432);
    bf16_t* att = (bf16_t*)(smem + 5120 + 36864);
    bf16_t* ST = (bf16_t*)(smem + 5120 + 46080);
    float* dsT = (float*)(p.ws + OFF_R5) + (size_t)item * 8192;
    if (tid < 128) {
        const int s = tid >> 1, hf = tid & 1;
        const uint4 a = *(const uint4*)((const bf16_t*)(p.ws + OFF_LRB) + (t0 + s) * 16 + hf * 8);
        float4* d = (float4*)(lrs + s * 16 + hf * 8);
        d[0] = make_float4(lo_bf(a.x), hi_bf(a.x), lo_bf(a.y), hi_bf(a.y));
        d[1] = make_float4(lo_bf(a.z), hi_bf(a.z), lo_bf(a.w), hi_bf(a.w));
    }
    {
        const int vv = tid & 127, sh = tid >> 7;
#pragma unroll 8
        for (int j = 0; j < 32; ++j) {
            const int s = sh * 32 + j;
            vT[vv * 72 + s] = pr[(size_t)s * PROJ_LD + C_V + h * 128 + vv];
        }
    }
    if (pass == 3) {
#pragma unroll 8
        for (int i = 0; i < 32; ++i) {
            const int idx = tid + i * 256;
            ST[(idx >> 6) * 72 + (idx & 63)] = f2bf(dsT[idx]);
        }
    }
    __syncthreads();
    {
        const int kk = lane, sg = wave;
        const int col = h * 64 + kk;
        float wl[16];
#pragma unroll
        for (int r = 0; r < 16; ++r) wl[r] = p.in[13][(size_t)L * 16 * 256 + r * 256 + col];
        const float bl = p.in[14][L * 256 + col];
        float bcum[16];
        float run = 0.f;
#pragma unroll
        for (int j = 0; j < 16; ++j) {
            const float4* l4 = (const float4*)(lrs + (sg * 16 + j) * 16);
            float lg = bl;
#pragma unroll
            for (int i = 0; i < 4; ++i) { const float4 x = l4[i]; lg += x.x * wl[4 * i] + x.y * wl[4 * i + 1] + x.z * wl[4 * i + 2] + x.w * wl[4 * i + 3]; }
            run += logsigmoid_(lg) * (1.f / 16.f);
            bcum[j] = run;
        }
        tot[sg * 64 + kk] = run;
        __syncthreads();
        float off = 0.f, blast = 0.f;
#pragma unroll
        for (int gi = 0; gi < 4; ++gi) { const float t = tot[gi * 64 + kk]; blast += t; if (gi < sg) off += t; }
#pragma unroll
        for (int j = 0; j < 16; ++j) {
            const int s = sg * 16 + j;
            const float bv = bcum[j] + off;
            const float kv = bf2f(pr[(size_t)s * PROJ_LD + C_K + col]);
            if (pass == 3) {
                const float qv = bf2f(pr[(size_t)s * PROJ_LD + C_Q + col]);
                qd[s * 72 + kk] = f2bf(qv * 0.125f * __expf(bv));
                ki[s * 72 + kk] = f2bf(kv * __expf(-bv));
            } else {
                ki[kk * 72 + s] = f2bf(kv * __expf(blast - bv));
            }
        }
        if (pass == 1 && sg == 0) ((float*)(p.ws + OFF_DEC))[item * 64 + kk] = __expf(blast);
    }
    __syncthreads();
    const int fr = lane & 15, fq = lane >> 4;
    if (pass == 1) {
        f32x4 acc[2][4];
#pragma unroll
        for (int mi = 0; mi < 2; ++mi)
#pragma unroll
            for (int ni = 0; ni < 4; ++ni) acc[mi][ni] = (f32x4){0.f, 0.f, 0.f, 0.f};
#pragma unroll
        for (int ks = 0; ks < 2; ++ks) {
            bf16x8 af[2], bfr[4];
#pragma unroll
            for (int mi = 0; mi < 2; ++mi) af[mi] = *(const bf16x8*)(vT + (wave * 32 + mi * 16 + fr) * 72 + ks * 32 + fq * 8);
#pragma unroll
            for (int ni = 0; ni < 4; ++ni) bfr[ni] = *(const bf16x8*)(ki + (ni * 16 + fr) * 72 + ks * 32 + fq * 8);
#pragma unroll
            for (int mi = 0; mi < 2; ++mi)
#pragma unroll
                for (int ni = 0; ni < 4; ++ni) acc[mi][ni] = __builtin_amdgcn_mfma_f32_16x16x32_bf16(bfr[ni], af[mi], acc[mi][ni], 0, 0, 0);
        }
#pragma unroll
        for (int mi = 0; mi < 2; ++mi)
#pragma unroll
            for (int ni = 0; ni < 4; ++ni) *(f32x4*)(dsT + (wave * 32 + mi * 16 + fr) * 64 + ni * 16 + fq * 4) = acc[mi][ni];
    } else {
        const int c = wave * 16 + fr;
        {
            f32x4 aa[4];
#pragma unroll
            for (int ni = 0; ni < 4; ++ni) aa[ni] = (f32x4){0.f, 0.f, 0.f, 0.f};
#pragma unroll
            for (int ks = 0; ks < 2; ++ks) {
                const bf16x8 af = *(const bf16x8*)(qd + c * 72 + ks * 32 + fq * 8);
#pragma unroll
                for (int ni = 0; ni < 4; ++ni) {
                    const bf16x8 bfr = *(const bf16x8*)(ki + (ni * 16 + fr) * 72 + ks * 32 + fq * 8);
                    aa[ni] = __builtin_amdgcn_mfma_f32_16x16x32_bf16(bfr, af, aa[ni], 0, 0, 0);
                }
            }
#pragma unroll
            for (int ni = 0; ni < 4; ++ni) {
                const int s0 = ni * 16 + fq * 4;
                f32x4 v = aa[ni];
#pragma unroll
                for (int r = 0; r < 4; ++r) if (s0 + r > c) v[r] = 0.f;
                *(uint2*)(att + c * 72 + s0) = pack4(v);
            }
        }
        __syncthreads();
        f32x4 ao[8];
#pragma unroll
        for (int ni = 0; ni < 8; ++ni) ao[ni] = (f32x4){0.f, 0.f, 0.f, 0.f};
#pragma unroll
        for (int ks = 0; ks < 2; ++ks) {
            const bf16x8 af = *(const bf16x8*)(att + c * 72 + ks * 32 + fq * 8);
#pragma unroll
            for (int ni = 0; ni < 8; ++ni) {
                const bf16x8 bfr = *(const bf16x8*)(vT + (ni * 16 + fr) * 72 + ks * 32 + fq * 8);
                ao[ni] = __builtin_amdgcn_mfma_f32_16x16x32_bf16(bfr, af, ao[ni], 0, 0, 0);
            }
        }
#pragma unroll
        for (int ks = 0; ks < 2; ++ks) {
            const bf16x8 af = *(const bf16x8*)(qd + c * 72 + ks * 32 + fq * 8);
#pragma unroll
            for (int ni = 0; ni < 8; ++ni) {
                const bf16x8 bfr = *(const bf16x8*)(ST + (ni * 16 + fr) * 72 + ks * 32 + fq * 8);
                ao[ni] = __builtin_amdgcn_mfma_f32_16x16x32_bf16(bfr, af, ao[ni], 0, 0, 0);
            }
        }
        float ss = 0.f;
#pragma unroll
        for (int ni = 0; ni < 8; ++ni) ss += ao[ni][0] * ao[ni][0] + ao[ni][1] * ao[ni][1] + ao[ni][2] * ao[ni][2] + ao[ni][3] * ao[ni][3];
        ss += __shfl_xor(ss, 16);
        ss += __shfl_xor(ss, 32);
        const float rinv = rsqrtf(ss * (1.f / 128.f) + LN_EPS);
        const float* ng = p.in[15] + L * 128;
#pragma unroll
        for (int ni = 0; ni < 8; ++ni) {
            const int v0 = ni * 16 + fq * 4;
            bf16_t* op = pr + (size_t)c * PROJ_LD + C_OG + h * 128 + v0;
            const uint2 ogp = *(const uint2*)op;
            const float4 gg = *(const float4*)(ng + v0);
            f32x4 y;
            float o0 = lo_bf(ogp.x), o1 = hi_bf(ogp.x), o2 = lo_bf(ogp.y), o3 = hi_bf(ogp.y);
            y[0] = ao[ni][0] * rinv * gg.x * (o0 * sigmoid_(o0));
            y[1] = ao[ni][1] * rinv * gg.y * (o1 * sigmoid_(o1));
            y[2] = ao[ni][2] * rinv * gg.z * (o2 * sigmoid_(o2));
            y[3] = ao[ni][3] * rinv * gg.w * (o3 * sigmoid_(o3));
            *(uint2*)op = pack4(y);
        }
    }
    __syncthreads();
}
__device__ void gla_scan(const Params& p, int item) {
    const int id = item * 256 + TID();
    const int e = id & 8191, bh = id >> 13, kk = e & 63;
    float* dsT = (float*)(p.ws + OFF_R5) + (size_t)bh * 64 * 8192 + e;
    const float* dec = (const float*)(p.ws + OFF_DEC) + (size_t)bh * 64 * 64 + kk;
    float S = 0.f;
#pragma unroll 4
    for (int n = 0; n < 64; ++n) {
        const float d = dsT[(size_t)n * 8192];
        dsT[(size_t)n * 8192] = S;
        S = dec[n * 64] * S + d;
    }
}

__device__ void softmax_item(const Params& p, int item) {
    const int lane = TID() & 63, wave = TID() >> 6;
    bf16_t* S = (bf16_t*)(p.ws + OFF_XS);
#pragma unroll
    for (int r = 0; r < 4; ++r) {
        const size_t row = (size_t)item * 16 + wave * 4 + r;
        uint2* ptr = (uint2*)(S + row * 256) + lane;
        const uint2 v = *ptr;
        float a = lo_bf(v.x), b = hi_bf(v.x), c = lo_bf(v.y), d = hi_bf(v.y);
        const float mx = wave_max(fmaxf(fmaxf(a, b), fmaxf(c, d)));
        a = __expf(a - mx); b = __expf(b - mx); c = __expf(c - mx); d = __expf(d - mx);
        const float inv = 1.f / wave_sum(a + b + c + d);
        uint2 o; o.x = cvt_pk_bf16(a * inv, b * inv); o.y = cvt_pk_bf16(c * inv, d * inv);
        *ptr = o;
    }
}

#define PG8_LAS __attribute__((address_space(3)))
constexpr int G8_HTB = 128 * 64 * 2;
__device__ __forceinline__ int lds_byte(int r, int c) { const int st = (r >> 4) * 2 + (c >> 5), rr = r & 15, cc = c & 31, ob = rr * 64 + cc * 2; return st * 1024 + (ob ^ (((ob >> 9) & 1) << 5)); }
__device__ __forceinline__ void stage_rc(int b, int& R, int& C) { const int st = b / 1024, sb = b % 1024, swz = sb ^ (((sb >> 9) & 1) << 5); R = (st >> 1) * 16 + swz / 64; C = (st & 1) * 32 + (swz % 64) / 2; }
struct G8 { const bf16_t* A; const bf16_t* Bt; int lda, ldb, K, nM, nN, nZ; long sA0, sA1, sB0, sB1; };
__device__ __forceinline__ bool g8_unit(const G8& g, int i, int& pm, int& pn, int& z) {
    const int per = g.nM * g.nN;
    const long L = (long)i * gridDim.x + blockIdx.x;
    if (L >= (long)per * g.nZ) return false;
    z = (int)(L / per);
    int wgid = (int)(L - (long)z * per);
    { const int q = per / 8, r = per % 8, xcd = wgid % 8, off = wgid / 8; wgid = (xcd < r ? xcd * (q + 1) : r * (q + 1) + (xcd - r) * q) + off; }
    const int nig = 8 * g.nN, gid = wgid / nig, fm = gid * 8, gsz = (g.nM - fm) < 8 ? (g.nM - fm) : 8;
    pm = fm + ((wgid % nig) % gsz); pn = (wgid % nig) / gsz;
    return true;
}
template <class Epi>
__device__ __forceinline__ void gemm8(PG8_LAS unsigned char* lds, const G8 g, const Epi& E) {
    const int tid = TIDX(), wid = __builtin_amdgcn_readfirstlane(tid >> 6), lane = tid & 63, wr = wid >> 2, wc = wid & 3, fr = lane & 15, fq = lane >> 4;
    const int nt = g.K / 64;
    unsigned voffA[2], voffB[2];
#pragma unroll
    for (int i = 0; i < 2; ++i) { int R, C; stage_rc(tid * 16 + i * 8192, R, C); voffA[i] = (unsigned)(R * g.lda + C) * 2u; voffB[i] = (unsigned)(R * g.ldb + C) * 2u; }
    const size_t kstep = 128;
    const size_t hstepA = (size_t)128 * g.lda * 2, hstepB = (size_t)128 * g.ldb * 2;
    const unsigned ldsw = (unsigned)wid * 1024u;
    const int aoff = lds_byte(wr * 64 + fr, fq * 8), boff = lds_byte(wc * 32 + fr, fq * 8);
#define PG8_SA(b, h) (((b) * 2 + (h)) * G8_HTB)
#define PG8_SB(b, h) ((4 + (b) * 2 + (h)) * G8_HTB)
#define PG8_STAGE(bufoff, gbase, voff) do { _Pragma("unroll") for (int _i = 0; _i < 2; ++_i) \
        __builtin_amdgcn_global_load_lds((const unsigned*)((const char*)(gbase) + (voff)[_i]), (PG8_LAS unsigned*)(lds + (bufoff) + ldsw + _i * 8192), 16, 0, 0); } while (0)
#define PG8_LDA(dst, b, h) do { _Pragma("unroll") for (int m = 0; m < 4; ++m) _Pragma("unroll") for (int k = 0; k < 2; ++k) dst[m][k] = *(const PG8_LAS bf16x8*)(lds + PG8_SA(b, h) + aoff + m * 2048 + k * 1024); } while (0)
#define PG8_LDB(dst, b, h) do { _Pragma("unroll") for (int n = 0; n < 2; ++n) _Pragma("unroll") for (int k = 0; k < 2; ++k) dst[n][k] = *(const PG8_LAS bf16x8*)(lds + PG8_SB(b, h) + boff + n * 2048 + k * 1024); } while (0)
#define PG8_MMA(ai, bj, At, Bt) do { __builtin_amdgcn_s_setprio(1); _Pragma("unroll") for (int m = 0; m < 4; ++m) _Pragma("unroll") for (int n = 0; n < 2; ++n) _Pragma("unroll") for (int k = 0; k < 2; ++k) \
        acc[ai][bj][m][n] = __builtin_amdgcn_mfma_f32_16x16x32_bf16(Bt[n][k], At[m][k], acc[ai][bj][m][n], 0, 0, 0); __builtin_amdgcn_s_setprio(0); } while (0)
#define PG8_WAIT_V(n) asm volatile("s_waitcnt vmcnt(" #n ")" ::: "memory")
#define PG8_WAIT_L(n) asm volatile("s_waitcnt lgkmcnt(" #n ")" ::: "memory")
#define PG8_BAR __builtin_amdgcn_s_barrier()
#define PG8_SCHED __builtin_amdgcn_sched_barrier(0)
    int cpm, cpn, cz, npm, npn, nz, ui = 0;
    if (!g8_unit(g, 0, cpm, cpn, cz)) return;
    f32x4 acc[2][2][4][2];
#pragma unroll
    for (int a = 0; a < 2; ++a)
#pragma unroll
        for (int b = 0; b < 2; ++b)
#pragma unroll
            for (int m = 0; m < 4; ++m)
#pragma unroll
                for (int n = 0; n < 2; ++n) acc[a][b][m][n] = (f32x4){0.f, 0.f, 0.f, 0.f};
    bf16x8 At[4][2], B0[2][2], B1[2][2];
    const char* cA = (const char*)(g.A + (cz & 3) * g.sA0 + (cz >> 2) * g.sA1 + (size_t)cpm * 256 * g.lda);
    const char* cB = (const char*)(g.Bt + (cz & 3) * g.sB0 + (cz >> 2) * g.sB1 + (size_t)cpn * 256 * g.ldb);
    PG8_STAGE(PG8_SB(0, 0), cB, voffB); PG8_STAGE(PG8_SA(0, 0), cA, voffA); PG8_STAGE(PG8_SB(0, 1), cB + hstepB, voffB); PG8_STAGE(PG8_SA(0, 1), cA + hstepA, voffA);
    if (wr == 1) PG8_BAR;
    PG8_WAIT_V(4); PG8_BAR;
    PG8_STAGE(PG8_SB(1, 0), cB + kstep, voffB); PG8_STAGE(PG8_SA(1, 0), cA + kstep, voffA); PG8_STAGE(PG8_SB(1, 1), cB + hstepB + kstep, voffB);
    PG8_WAIT_V(6); PG8_BAR;
    for (;;) {
        const bool has_next = g8_unit(g, ui + 1, npm, npn, nz);
        const char* nA = has_next ? (const char*)(g.A + (nz & 3) * g.sA0 + (nz >> 2) * g.sA1 + (size_t)npm * 256 * g.lda) : cA;
        const char* nB = has_next ? (const char*)(g.Bt + (nz & 3) * g.sB0 + (nz >> 2) * g.sB1 + (size_t)npn * 256 * g.ldb) : cB;
        for (int t = 0; t < nt; t += 2) {
            const bool last = (t == nt - 2);
            const char* a1 = cA + (size_t)(t + 1) * kstep;
            const char* a2 = last ? nA : cA + (size_t)(t + 2) * kstep; const char* b2 = last ? nB : cB + (size_t)(t + 2) * kstep;
            const char* a3 = a2 + kstep; const char* b3 = b2 + kstep;
            PG8_LDB(B0, 0, 0); PG8_SCHED; PG8_LDA(At, 0, 0); PG8_STAGE(PG8_SA(1, 1), a1 + hstepA, voffA);
            PG8_WAIT_L(8); PG8_BAR; PG8_WAIT_L(0); PG8_MMA(0, 0, At, B0); PG8_BAR; PG8_SCHED;
            PG8_LDB(B1, 0, 1); PG8_STAGE(PG8_SB(0, 0), b2, voffB);
            PG8_BAR; PG8_WAIT_L(0); PG8_MMA(0, 1, At, B1); PG8_BAR;
            PG8_LDA(At, 0, 1); PG8_STAGE(PG8_SA(0, 0), a2, voffA);
            PG8_BAR; PG8_WAIT_L(0); PG8_MMA(1, 0, At, B0); PG8_BAR; PG8_SCHED;
            PG8_STAGE(PG8_SB(0, 1), b2 + hstepB, voffB);
            PG8_WAIT_V(6); PG8_BAR; PG8_MMA(1, 1, At, B1); PG8_BAR;
            PG8_LDB(B0, 1, 0); PG8_SCHED; PG8_LDA(At, 1, 0); PG8_STAGE(PG8_SA(0, 1), a2 + hstepA, voffA);
            PG8_WAIT_L(8); PG8_BAR; PG8_WAIT_L(0); PG8_MMA(0, 0, At, B0); PG8_BAR; PG8_SCHED;
            PG8_LDB(B1, 1, 1); PG8_STAGE(PG8_SB(1, 0), b3, voffB);
            PG8_BAR; PG8_WAIT_L(0); PG8_MMA(0, 1, At, B1); PG8_BAR;
            PG8_LDA(At, 1, 1); PG8_STAGE(PG8_SA(1, 0), a3, voffA);
            PG8_BAR; PG8_WAIT_L(0); PG8_MMA(1, 0, At, B0); PG8_BAR; PG8_SCHED;
            PG8_STAGE(PG8_SB(1, 1), b3 + hstepB, voffB);
            PG8_WAIT_V(6); PG8_BAR; PG8_MMA(1, 1, At, B1); PG8_BAR;
        }
        E(acc, cpm, cpn, cz, wr, wc, fr, fq);
        if (!has_next) break;
#pragma unroll
        for (int a = 0; a < 2; ++a)
#pragma unroll
            for (int b = 0; b < 2; ++b)
#pragma unroll
                for (int m = 0; m < 4; ++m)
#pragma unroll
                    for (int n = 0; n < 2; ++n) acc[a][b][m][n] = (f32x4){0.f, 0.f, 0.f, 0.f};
        cpm = npm; cpn = npn; cz = nz; cA = nA; cB = nB; ++ui;
    }
    PG8_WAIT_V(0);
    if (wr == 0) PG8_BAR;
    PG8_BAR;
#undef PG8_SA
#undef PG8_SB
#undef PG8_STAGE
#undef PG8_LDA
#undef PG8_LDB
#undef PG8_MMA
#undef PG8_WAIT_V
#undef PG8_WAIT_L
#undef PG8_BAR
#undef PG8_SCHED
}
template <class F>
__device__ __forceinline__ void g8_foreach(const f32x4 (&acc)[2][2][4][2], int pm, int pn, int wr, int wc, int fr, int fq, F f) {
#pragma unroll
    for (int ai = 0; ai < 2; ++ai)
#pragma unroll
        for (int m = 0; m < 4; ++m)
#pragma unroll
            for (int bj = 0; bj < 2; ++bj)
#pragma unroll
                for (int n = 0; n < 2; ++n) f(pm * 256 + ai * 128 + wr * 64 + m * 16 + fr, pn * 256 + bj * 128 + wc * 32 + n * 16 + fq * 4, acc[ai][bj][m][n]);
}
struct EpiResid {
    float* out;
    __device__ __forceinline__ void operator()(const f32x4 (&acc)[2][2][4][2], int pm, int pn, int z, int wr, int wc, int fr, int fq) const {
        float* o = out;
        g8_foreach(acc, pm, pn, wr, wc, fr, fq, [&](int row, int col, f32x4 v) { f32x4* q = (f32x4*)(o + (size_t)row * DM + col); const f32x4 h = *q; *q = h * DN_ALPHA + v; });
    }
};
struct EpiBf16 {
    bf16_t* C; int ldc; long sC0, sC1; float scale;
    __device__ __forceinline__ void operator()(const f32x4 (&acc)[2][2][4][2], int pm, int pn, int z, int wr, int wc, int fr, int fq) const {
        bf16_t* c = C + (z & 3) * sC0 + (z >> 2) * sC1; const int ld = ldc; const float sc = scale;
        g8_foreach(acc, pm, pn, wr, wc, fr, fq, [&](int row, int col, f32x4 v) { *(uint2*)(c + (size_t)row * ld + col) = pack4(v * sc); });
    }
};
struct EpiProj {
    bf16_t* R3; const float* bias;
    __device__ __forceinline__ void operator()(const f32x4 (&acc)[2][2][4][2], int pm, int pn, int z, int wr, int wc, int fr, int fq) const {
        bf16_t* c = R3; const float* b = bias;
        g8_foreach(acc, pm, pn, wr, wc, fr, fq, [&](int row, int col, f32x4 v) {
            const f32x4 bv = *(const f32x4*)(b + (col < 2560 ? col : col + 16));
            *(uint2*)(c + (size_t)row * PROJ_LD + col) = pack4(v + bv); });
    }
};
__device__ __forceinline__ bf16_t* gate_ptr(char* ws, int n, int row, int col) {
    if (n == 1) return (bf16_t*)(ws + OFF_R3) + (size_t)row * PROJ_LD + 512 + col + (col >= 512 ? 512 : 0);
    return (bf16_t*)(ws + OFF_GL) + (size_t)row * DM + col;
}
struct EpiGate {
    char* ws; const float* bias; int n0;
    __device__ __forceinline__ void operator()(const f32x4 (&acc)[2][2][4][2], int pm, int pn, int z, int wr, int wc, int fr, int fq) const {
        char* w = ws; const float* b = bias; const int nb = n0;
        g8_foreach(acc, pm, pn, wr, wc, fr, fq, [&](int row, int col, f32x4 v) {
            const f32x4 bv = *(const f32x4*)(b + col);
            f32x4 s; s[0] = sigmoid_(v[0] + bv[0]); s[1] = sigmoid_(v[1] + bv[1]); s[2] = sigmoid_(v[2] + bv[2]); s[3] = sigmoid_(v[3] + bv[3]);
            *(uint2*)gate_ptr(w, nb + (col >> 10), row, col & 1023) = pack4(s); });
    }
};
struct EpiBranch {
    char* ws; int n0;
    __device__ __forceinline__ void operator()(const f32x4 (&acc)[2][2][4][2], int pm, int pn, int z, int wr, int wc, int fr, int fq) const {
        char* w = ws; const int n = n0 + z;
        bf16_t* mg = (bf16_t*)(w + OFF_R5);
        g8_foreach(acc, pm, pn, wr, wc, fr, fq, [&](int row, int col, f32x4 v) {
            const uint2 gp = *(const uint2*)gate_ptr(w, n, row, col);
            uint2* mp = (uint2*)(mg + (size_t)row * DM + col);
            f32x4 r; r[0] = lo_bf(gp.x) * v[0]; r[1] = hi_bf(gp.x) * v[1]; r[2] = lo_bf(gp.y) * v[2]; r[3] = hi_bf(gp.y) * v[3];
            if (n != 0) { const uint2 o = *mp; r[0] += lo_bf(o.x); r[1] += hi_bf(o.x); r[2] += lo_bf(o.y); r[3] += hi_bf(o.y); }
            *mp = pack4(r); });
    }
};
struct EpiSwiglu {
    bf16_t* act;
    __device__ __forceinline__ void operator()(const f32x4 (&acc)[2][2][4][2], int pm, int pn, int z, int wr, int wc, int fr, int fq) const {
#pragma unroll
        for (int ai = 0; ai < 2; ++ai)
#pragma unroll
            for (int m = 0; m < 4; ++m)
#pragma unroll
                for (int n = 0; n < 2; ++n) {
                    const int row = pm * 256 + ai * 128 + wr * 64 + m * 16 + fr, col = pn * 128 + wc * 32 + n * 16 + fq * 4;
                    f32x4 y;
#pragma unroll
                    for (int r = 0; r < 4; ++r) { const float gte = acc[ai][0][m][n][r]; y[r] = gte * sigmoid_(gte) * acc[ai][1][m][n][r]; }
                    *(uint2*)(act + (size_t)row * DFF + col) = pack4(y);
                }
    }
};

constexpr int PH_PER_LAYER = 20, N_PHASES = 1 + 2 * PH_PER_LAYER;

__device__ void run_phase(const Params& p, int ph, char* smem_all) {
    const int G2 = gridDim.x * 2;
    const int hf = __builtin_amdgcn_readfirstlane(TIDX() >> 8);
    const int B2 = blockIdx.x * 2 + hf;
    char* smem = smem_all + hf * HALF_SMEM;
    PG8_LAS unsigned char* lds = (PG8_LAS unsigned char*)smem_all;
    char* ws = p.ws;
    bf16_t* hb = (bf16_t*)(ws + OFF_HB);
    if (ph == 0) {
        const int nconv = p.wa[0][NWA - 1].tile_end;
        const int nmem = 1024 * 1024 / (256 * 8);
        const int nln = NTOK / 4;
        for (int it = B2; it < nconv + nmem + nln; it += G2) {
            if (it < nconv) conv_w_set(p.wa[0], NWA, it, smem);
            else if (it < nconv + nmem) {
                const size_t i8 = ((size_t)(it - nconv) * 256 + TID()) * 8;
                const float4 a = *(const float4*)(p.in[1] + i8), b = *(const float4*)(p.in[1] + i8 + 4);
                uint4 o; o.x = cvt_pk_bf16(a.x, a.y); o.y = cvt_pk_bf16(a.z, a.w); o.z = cvt_pk_bf16(b.x, b.y); o.w = cvt_pk_bf16(b.z, b.w);
                *(uint4*)((bf16_t*)(ws + OFF_MEMB) + i8) = o;
            } else ln_rows(p.in[0], p.out, hb, p.in[2], p.in[3], it - nconv - nmem);
        }
        return;
    }
    const int L = (ph - 1) / PH_PER_LAYER, q = (ph - 1) % PH_PER_LAYER;
    bf16_t* R3 = (bf16_t*)(ws + OFF_R3);
    const bf16_t* Wt = (const bf16_t*)(ws + WT_IN);
    switch (q) {
    case 0: {
        G8 g{hb, Wt, DM, DM, DM, 64, 12, 1, 0, 0, 0, 0};
        gemm8(lds, g, EpiProj{R3, p.in[5] + (size_t)L * 6160});
        const int lane = TIDX() & 63, fr = lane & 15, fq = lane >> 4;
        const int wv = blockIdx.x * 8 + (TIDX() >> 6);
        if (wv < 1024) {
            const bf16_t* a = hb + (size_t)(wv * 16 + fr) * DM + fq * 8;
            const bf16_t* b = Wt + (size_t)(6144 + fr) * DM + fq * 8;
            f32x4 acc = {0.f, 0.f, 0.f, 0.f};
#pragma unroll 8
            for (int ks = 0; ks < 32; ++ks) acc = __builtin_amdgcn_mfma_f32_16x16x32_bf16(*(const bf16x8*)(b + ks * 32), *(const bf16x8*)(a + ks * 32), acc, 0, 0, 0);
            const f32x4 bv = *(const f32x4*)(p.in[5] + (size_t)L * 6160 + 2560 + fq * 4);
            *(uint2*)((bf16_t*)(ws + OFF_LRB) + (size_t)(wv * 16 + fr) * 16 + fq * 4) = pack4(acc + bv);
        }
    } break;
    case 1: {
        const int n1 = 1024, n2 = 2048, n3 = 4096;
        for (int it = B2; it < n1 + n2 + n3; it += G2) {
            if (it < n1) gla_item(p, L, it, 1, smem);
            else if (it < n1 + n2) s5_item(p, L, it - n1, 1, smem);
            else dwconv_item(p, L, it - n1 - n2);
        }
    } break;
    case 2: {
        const int n1 = 128 * 2 * 4, n2 = 512;
        const bf16_t* uc = (const bf16_t*)(ws + OFF_UC);
        const bf16_t* Wl = (const bf16_t*)(ws + WT_LRU);
        bf16_t* gl = (bf16_t*)(ws + OFF_GL);
        for (int it = B2; it < n1 + n2; it += G2) {
            if (it < n1) {
                const int z = it & 3, nt = (it >> 2) & 1, mt = it >> 3;
                const float* bias = (nt == 0 ? p.in[9] : p.in[11]) + L * 512 + z * 128 - nt * 128;
                gemm_tile_bf16(uc + z * 128, 512, Wl + (size_t)z * 256 * 128, 128, 128, gl + z * 256, 1024, mt * 128, nt * 128, bias, 1.f, smem);
            } else gla_scan(p, it - n1);
        }
    } break;
    case 3: {
        const int n1 = 1024, n2 = 2048, n3 = 512;
        for (int it = B2; it < n1 + n2 + n3; it += G2) {
            if (it < n1) gla_item(p, L, it, 3, smem);
            else if (it < n1 + n2) s5_item(p, L, it - n1, 3, smem);
            else lru_pass(p, L, it - n1 - n2, 1);
        }
    } break;
    case 4: {
        const int n1 = 128 * 4, n2 = 512;
        const bf16_t* Wg = (const bf16_t*)(ws + WT_GLU);
        bf16_t* yc = R3 + C_Q;
        const float* bias = p.in[25] + L * 512;
        for (int it = B2; it < n1 + n2; it += G2) {
            if (it < n1) {
                const int mt = it >> 2, nt = it & 3;
                const int m0 = mt * 128, n0 = nt * 128;
                f32x4 acc[4][4];
                zero_acc<4>(acc);
                gemm_mainloop<4>(acc, R3 + (size_t)m0 * PROJ_LD + C_US5, PROJ_LD, Wg + (size_t)n0 * 512, 512, 512, smem);
                epi_foreach<4>(acc, m0, n0, [&](int row, int col, f32x4 v) {
                    const f32x4 bv = *(const f32x4*)(bias + col);
                    const uint2 zz = *(const uint2*)(R3 + (size_t)row * PROJ_LD + C_US5 + col);
                    f32x4 y;
                    y[0] = lo_bf(zz.x) * sigmoid_(v[0] + bv[0]); y[1] = hi_bf(zz.x) * sigmoid_(v[1] + bv[1]);
                    y[2] = lo_bf(zz.y) * sigmoid_(v[2] + bv[2]); y[3] = hi_bf(zz.y) * sigmoid_(v[3] + bv[3]);
                    *(uint2*)(yc + (size_t)row * PROJ_LD + col) = pack4(y);
                });
            } else lru_pass(p, L, it - n1, 3);
        }
    } break;
    case 5: {
        G8 g{hb, Wt + (size_t)3072 * DM, DM, DM, DM, 64, 8, 1, 0, 0, 0, 0};
        gemm8(lds, g, EpiGate{ws, p.in[5] + (size_t)L * 6160 + 3088, 0});
    } break;
    case 6: {
        G8 g{R3 + C_ULRU, (const bf16_t*)(ws + WT_BR), PROJ_LD, 512, 512, 64, 4, 2, (long)(C_OG - C_ULRU), 0, 1024L * 512, 0};
        gemm8(lds, g, EpiBranch{ws, 0});
    } break;
    case 7: {
        G8 g{hb, Wt + (size_t)(3072 + 2048) * DM, DM, DM, DM, 64, 4, 1, 0, 0, 0, 0};
        gemm8(lds, g, EpiGate{ws, p.in[5] + (size_t)L * 6160 + 3088 + 2048, 2});
    } break;
    case 8: {
        G8 g{R3 + C_Q, (const bf16_t*)(ws + WT_BR) + 2ull * 1024 * 512, PROJ_LD, 512, 512, 64, 4, 1, 0, 0, 0, 0};
        gemm8(lds, g, EpiBranch{ws, 2});
    } break;
    case 9: {
        G8 g{(const bf16_t*)(ws + OFF_R5), (const bf16_t*)(ws + WT_MIX), DM, DM, DM, 64, 4, 1, 0, 0, 0, 0};
        gemm8(lds, g, EpiResid{p.out});
    } break;
    case 10: {
        const int n1 = NTOK / 4, n2 = p.wb[L][NWB - 1].tile_end;
        for (int it = B2; it < n1 + n2; it += G2) {
            if (it < n1) ln_rows(p.out, p.out, hb, p.in[28] + L * DM, p.in[29] + L * DM, it);
            else conv_w_set(p.wb[L], NWB, it - n1, smem);
        }
    } break;
    case 11: {
        G8 g{hb, (const bf16_t*)(ws + WT_Q), DM, DM, DM, 64, 4, 1, 0, 0, 0, 0};
        gemm8(lds, g, EpiBf16{(bf16_t*)(ws + OFF_XQ), DM, 0, 0, 0.0625f});
        const bf16_t* Wkv = (const bf16_t*)(ws + WT_KV);
        const bf16_t* memb = (const bf16_t*)(ws + OFF_MEMB);
        for (int it = B2; it < 128; it += G2) {
            const int t = it & 63;
            if (it < 64) gemm_tile_bf16(memb, DM, Wkv, DM, DM, (bf16_t*)(ws + OFF_KB), DM, (t >> 3) * 128, (t & 7) * 128, nullptr, 1.f, smem);
            else gemm_tile_bf16(Wkv + (size_t)1024 * DM, DM, memb, DM, DM, (bf16_t*)(ws + OFF_VT), DM, (t >> 3) * 128, (t & 7) * 128, nullptr, 1.f, smem);
        }
    } break;
    case 12: {
        G8 g{(const bf16_t*)(ws + OFF_XQ), (const bf16_t*)(ws + OFF_KB), DM, DM, 256, 16, 1, 16, 256, (long)SEQ * DM, 256, 256L * DM};
        gemm8(lds, g, EpiBf16{(bf16_t*)(ws + OFF_XS), 256, (long)SEQ * 256, 4L * SEQ * 256, 1.f});
    } break;
    case 13: {
        for (int it = B2; it < 4096; it += G2) softmax_item(p, it);
    } break;
    case 14: {
        G8 g{(const bf16_t*)(ws + OFF_XS), (const bf16_t*)(ws + OFF_VT), 256, DM, 256, 16, 1, 16, (long)SEQ * 256, 4L * SEQ * 256, 256L * DM, 256};
        gemm8(lds, g, EpiBf16{(bf16_t*)(ws + OFF_XO), DM, 256, (long)SEQ * DM, 1.f});
    } break;
    case 15: {
        G8 g{(const bf16_t*)(ws + OFF_XO), (const bf16_t*)(ws + WT_O), DM, DM, DM, 64, 4, 1, 0, 0, 0, 0};
        gemm8(lds, g, EpiResid{p.out});
    } break;
    case 16: {
        const int n1 = NTOK / 4, n2 = (L + 1 < 2) ? p.wa[1][NWA - 1].tile_end : 0;
        for (int it = B2; it < n1 + n2; it += G2) {
            if (it < n1) ln_rows(p.out, p.out, hb, p.in[33] + L * DM, p.in[34] + L * DM, it);
            else conv_w_set(p.wa[1], NWA, it - n1, smem);
        }
    } break;
    case 17: {
        G8 g{hb, (const bf16_t*)(ws + WT_GU), DM, DM, DM, 64, 22, 1, 0, 0, 0, 0};
        gemm8(lds, g, EpiSwiglu{(bf16_t*)(ws + OFF_ACT)});
    } break;
    case 18: {
        G8 g{(const bf16_t*)(ws + OFF_ACT), (const bf16_t*)(ws + WT_DN), DFF, DFF, DFF, 64, 4, 1, 0, 0, 0, 0};
        gemm8(lds, g, EpiResid{p.out});
    } break;
    case 19: {
        for (int it = B2; it < NTOK / 4; it += G2) ln_rows(p.out, p.out, hb, p.in[37] + L * DM, p.in[38] + L * DM, it);
    } break;
    }
}

#define XB_TMO      128
#define XB_XCNT(j)  (256  + 64 * (j))
#define XB_XSUB(j)  (1280 + 64 * (j))
#define XB_XGEN(j)  (2304 + 64 * (j))
#define XB_TOP      3328
#define XB_TOPGEN   3392
#define XCD_BAR_WORDS 3456
#define XB_SPIN_CAP (1u << 21)
#define LAS __attribute__((address_space(3)))
__device__ __forceinline__ unsigned xb_ld(unsigned* p)              { return __hip_atomic_load(p, __ATOMIC_RELAXED, __HIP_MEMORY_SCOPE_AGENT); }
__device__ __forceinline__ unsigned xb_add(unsigned* p, unsigned v) { return __hip_atomic_fetch_add(p, v, __ATOMIC_RELAXED, __HIP_MEMORY_SCOPE_AGENT); }
__device__ __forceinline__ unsigned xb_xcc_id() { return (unsigned)__builtin_amdgcn_s_getreg((3 << 11) | 20) & 0xFu; }
#define XB_SPIN(cond, bar) do { unsigned _sp = 0; while (cond) { __builtin_amdgcn_s_sleep(1); \
    if ((++_sp & 255u) == 0u) { if (xb_ld(&(bar)[XB_TMO])) break; if (_sp > XB_SPIN_CAP) { atomicAdd(&(bar)[XB_TMO], 1u); break; } } } } while (0)
struct XcdBarrier { unsigned* bar; unsigned x; volatile LAS unsigned* st; };
__device__ __forceinline__ XcdBarrier xcd_barrier_post(unsigned* bar, volatile LAS unsigned* st) {
    XcdBarrier b; b.bar = bar; b.x = xb_xcc_id(); b.st = st;
    if (threadIdx.x == 0) (void)xb_add(&bar[XB_XCNT(b.x)], 1u);
    return b;
}
__device__ __forceinline__ void xcd_barrier_complete(unsigned* bar, unsigned x, unsigned& nloc, unsigned& nx) {
    const unsigned G = gridDim.x * gridDim.y * gridDim.z;
    unsigned sum, cnt, mine, sp = 0u;
    for (;;) {
        sum = 0u; cnt = 0u; mine = 0u;
#pragma unroll
        for (unsigned j = 0; j < 16; ++j) { const unsigned c = xb_ld(&bar[XB_XCNT(j)]); sum += c; cnt += (c > 0u) ? 1u : 0u; mine = (j == x) ? c : mine; }
        if (sum == G) break;
        __builtin_amdgcn_s_sleep(1);
        if ((++sp & 255u) == 0u) { if (xb_ld(&bar[XB_TMO])) break; if (sp > XB_SPIN_CAP) { atomicAdd(&bar[XB_TMO], 1u); break; } }
    }
    nloc = mine > 0u ? mine : 1u; nx = cnt > 0u ? cnt : 1u;
}
__device__ __forceinline__ void xcd_barrier(const XcdBarrier& b) {
    asm volatile("s_waitcnt vmcnt(0)" ::: "memory");
    __syncthreads();
    if (threadIdx.x == 0) {
        unsigned* bar = b.bar;
        __builtin_amdgcn_s_waitcnt(0);
        unsigned nloc = b.st[0], nx = b.st[1];
        if (nloc == 0u) { xcd_barrier_complete(bar, b.x, nloc, nx); b.st[0] = nloc; b.st[1] = nx; }
        const unsigned old = xb_add(&bar[XB_XSUB(b.x)], 1u);
        const unsigned gen = old / nloc;
        if (old + 1u == (gen + 1u) * nloc) {
            __builtin_amdgcn_fence(__ATOMIC_RELEASE, "agent");
            asm volatile("s_waitcnt vmcnt(0)" ::: "memory");
            const unsigned og = xb_add(&bar[XB_TOP], 1u);
            const unsigned tg = og / nx;
            if (og + 1u == (tg + 1u) * nx) xb_add(&bar[XB_TOPGEN], 1u);
            else XB_SPIN(xb_ld(&bar[XB_TOPGEN]) == tg, bar);
            __builtin_amdgcn_fence(__ATOMIC_ACQUIRE, "agent");
            xb_add(&bar[XB_XGEN(b.x)], 1u);
            asm volatile("s_waitcnt vmcnt(0)" ::: "memory");
        } else {
            XB_SPIN(xb_ld(&bar[XB_XGEN(b.x)]) == gen, bar);
            __builtin_amdgcn_fence(__ATOMIC_ACQUIRE, "agent");
            asm volatile("s_waitcnt vmcnt(0)" ::: "memory");
        }
    }
    __syncthreads();
}

__global__ void __launch_bounds__(512, 2) fwd_megakernel(Params p) {
    extern __shared__ __attribute__((aligned(16))) char smem[];
    cg::grid_group grid = cg::this_grid();
    if (threadIdx.x == 0) *(uint4*)(smem + XB_LDS_OFF) = make_uint4(0u, 0u, 0u, 0u);
    __syncthreads();
    XcdBarrier xb = xcd_barrier_post((unsigned*)(p.ws + OFF_BAR), (volatile LAS unsigned*)(smem + XB_LDS_OFF));
    if (p.ph_lo < 0) grid.sync();
    for (int ph = p.ph_lo; ph < p.ph_hi; ++ph) {
        run_phase(p, ph, smem);
        if (ph + 1 < p.ph_hi) xcd_barrier(xb);
    }
}

static void add_job(CJob* jobs, int& n, int& tiles, const float* src, bf16_t* dst, int ld, int K, int nrows, int mode) {
    tiles += (nrows / 64) * (K / 64);
    jobs[n].src = src; jobs[n].dst = dst; jobs[n].ld = ld; jobs[n].K = K; jobs[n].mode = mode; jobs[n].tile_end = tiles;
    ++n;
}

extern "C" void kernel_launch(void* const* d_in, const int* in_sizes, int n_in, void* d_out, int out_size, void* d_ws, size_t ws_size, hipStream_t stream) {
    static int grid_blocks = 0;
    if (grid_blocks == 0) {
        if (n_in != 39 || ws_size < WS_END) { fprintf(stderr, "kernel_launch: unexpected n_in %d or ws_size %zu (< %zu)\n", n_in, ws_size, (size_t)WS_END); grid_blocks = -1; return; }
        int dev = 0, cus = 0, per_cu = 0;
        (void)hipGetDevice(&dev);
        (void)hipDeviceGetAttribute(&cus, hipDeviceAttributeMultiprocessorCount, dev);
        if (hipFuncSetAttribute((const void*)fwd_megakernel, hipFuncAttributeMaxDynamicSharedMemorySize, SMEM_BYTES) != hipSuccess) { fprintf(stderr, "hipFuncSetAttribute failed\n"); grid_blocks = -1; return; }
        if (hipOccupancyMaxActiveBlocksPerMultiprocessor(&per_cu, (const void*)fwd_megakernel, 512, SMEM_BYTES) != hipSuccess || per_cu < 1) { fprintf(stderr, "occupancy query failed\n"); grid_blocks = -1; return; }
        grid_blocks = cus;
    }
    if (grid_blocks < 0) return;
    Params p{};
    for (int i = 0; i < 39; ++i) p.in[i] = (const float*)d_in[i];
    p.out = (float*)d_out;
    p.ws = (char*)d_ws;
    char* ws = (char*)d_ws;
    for (int L = 0; L < 2; ++L) {
        int n = 0, t = 0;
        add_job(p.wa[L], n, t, p.in[4] + (size_t)L * 1024 * 6160, (bf16_t*)(ws + WT_IN), 6160, 1024, 6208, 1);
        for (int h = 0; h < 4; ++h) {
            add_job(p.wa[L], n, t, p.in[8] + (size_t)(L * 4 + h) * 128 * 128, (bf16_t*)(ws + WT_LRU) + (size_t)h * 256 * 128, 128, 128, 128, 0);
            add_job(p.wa[L], n, t, p.in[10] + (size_t)(L * 4 + h) * 128 * 128, (bf16_t*)(ws + WT_LRU) + (size_t)h * 256 * 128 + 128 * 128, 128, 128, 128, 0);
        }
        add_job(p.wa[L], n, t, p.in[24] + (size_t)L * 512 * 512, (bf16_t*)(ws + WT_GLU), 512, 512, 512, 0);
        for (int b = 0; b < 3; ++b) add_job(p.wa[L], n, t, p.in[26] + (size_t)(L * 3 + b) * 512 * 1024, (bf16_t*)(ws + WT_BR) + (size_t)b * 1024 * 512, 1024, 512, 1024, 0);
        add_job(p.wa[L], n, t, p.in[27] + (size_t)L * 1024 * 1024, (bf16_t*)(ws + WT_MIX), 1024, 1024, 1024, 0);
        n = 0; t = 0;
        add_job(p.wb[L], n, t, p.in[30] + (size_t)L * 1024 * 1024, (bf16_t*)(ws + WT_Q), 1024, 1024, 1024, 0);
        add_job(p.wb[L], n, t, p.in[31] + (size_t)L * 1024 * 2048, (bf16_t*)(ws + WT_KV), 2048, 1024, 2048, 0);
        add_job(p.wb[L], n, t, p.in[32] + (size_t)L * 1024 * 1024, (bf16_t*)(ws + WT_O), 1024, 1024, 1024, 0);
        add_job(p.wb[L], n, t, p.in[35] + (size_t)L * 1024 * 5632, (bf16_t*)(ws + WT_GU), 5632, 1024, 5632, 2);
        add_job(p.wb[L], n, t, p.in[36] + (size_t)L * 2816 * 1024, (bf16_t*)(ws + WT_DN), 1024, 2816, 1024, 0);
    }
    if (hipMemsetAsync(ws + OFF_BAR, 0, 3456 * 4, stream) != hipSuccess) { fprintf(stderr, "memset failed\n"); return; }
#if SINGLE_LAUNCH
    p.ph_lo = 0; p.ph_hi = N_PHASES;
    void* args[] = {&p};
    hipError_t e = hipLaunchCooperativeKernel((const void*)fwd_megakernel, dim3(grid_blocks), dim3(512), args, SMEM_BYTES, stream);
    if (e != hipSuccess) fprintf(stderr, "cooperative launch failed: %s (grid %d)\n", hipGetErrorString(e), grid_blocks);
#else
    for (int ph = 0; ph < N_PHASES; ++ph) {
        p.ph_lo = ph; p.ph_hi = ph + 1;
        hipLaunchKernelGGL(fwd_megakernel, dim3(grid_blocks), dim3(512), SMEM_BYTES, stream, p);
    }
#endif
}
```
